# Optimizing an MI355X kernel written in HIP

```python
import math
import jax, jax.numpy as jnp
from jax import lax
import numpy as np

D_MODEL = 2048
BATCH = 4
SEQ = 2048
DEPTH = 2
DEC_BATCH = 1
DEC_SEQ = 16384
PAST_LEN = 128

ATT_HEADS = 16
ATT_HEAD_DIM = 128
ATT_WIDTH = ATT_HEADS * ATT_HEAD_DIM
DILATED_PATTERNS = ((128, 1), (512, 4), (2048, 16))
POOL_WINDOWS = (2, 4, 8, 16)
POOL_WIDTH = D_MODEL // 2
POOL_GROUP = POOL_WIDTH // len(POOL_WINDOWS)
CONV_WIDTH = D_MODEL
CONV_TAPS = 3
REL_BUCKETS = 32
REL_MAX_DISTANCE = 1024
DN_ALPHA = (2 * DEPTH) ** 0.25
DN_BETA = (8 * DEPTH) ** -0.25
LN_EPS = 1e-5
NEG_INF = -1e30

N_EVEN = (DEPTH + 1) // 2
N_ODD = DEPTH // 2
IN_AB = 4 * ATT_WIDTH + 2 * POOL_WIDTH
IN_C = 4 * CONV_WIDTH

kernel_name = "hybrid_dilated_pool_shortconv_encoder"


def _t5_bucket(rel):
    nb = REL_BUCKETS // 2
    max_exact = nb // 2
    ret = np.where(rel > 0, nb, 0)
    n = np.abs(rel)
    n_safe = np.maximum(n, 1).astype(np.float64)
    large = max_exact + (np.log(n_safe / max_exact) / math.log(REL_MAX_DISTANCE / max_exact)
                         * (nb - max_exact)).astype(np.int64)
    large = np.minimum(large, nb - 1)
    return (ret + np.where(n < max_exact, n, large)).astype(np.int32)


def _layernorm(x, g, b):
    xf = x.astype(jnp.float32)
    mu = jnp.mean(xf, axis=-1, keepdims=True)
    var = jnp.mean(jnp.square(xf - mu), axis=-1, keepdims=True)
    return ((xf - mu) * lax.rsqrt(var + LN_EPS) * g + b).astype(x.dtype)


def _dilated_pattern(q, k, v, rel_bias, window, dilation):
    b, s, h, hd = q.shape
    r = window // (2 * dilation)
    L = s // dilation
    nb = -(-L // r)
    Lp = nb * r

    def to_strided(t):
        t = t.reshape(b, L, dilation, h, hd).transpose(0, 2, 1, 3, 4)
        return jnp.pad(t, ((0, 0), (0, 0), (0, Lp - L), (0, 0), (0, 0)))

    def band(t):
        tp = jnp.pad(t, ((0, 0), (0, 0), (r, r), (0, 0), (0, 0))).reshape(b, dilation, nb + 2, r, h, hd)
        return jnp.concatenate([tp[:, :, :-2], tp[:, :, 1:-1], tp[:, :, 2:]], axis=3)

    qb = to_strided(q).reshape(b, dilation, nb, r, h, hd)
    kb = band(to_strided(k))
    vb = band(to_strided(v))

    rel = np.arange(3 * r)[None, :] - r - np.arange(r)[:, None]
    in_band = np.abs(rel) <= r
    kpos = np.arange(nb)[:, None] * r - r + np.arange(3 * r)[None, :]
    valid = (kpos >= 0) & (kpos < L)
    mask = jnp.asarray(in_band[None, :, :] & valid[:, None, :])
    bias = rel_bias[_t5_bucket(rel * dilation)].astype(jnp.float32).transpose(2, 0, 1)

    scores = jnp.einsum('bgnqhd,bgnkhd->bgnhqk', qb, kb,
                        preferred_element_type=jnp.float32) * (ATT_HEAD_DIM ** -0.5)
    scores = jnp.where(mask[None, None, :, None], scores + bias[None, None, None], NEG_INF)
    m = jnp.max(scores, axis=-1, keepdims=True)
    p = jnp.exp(scores - m)
    den = jnp.sum(p, axis=-1)
    o = jnp.einsum('bgnhqk,bgnkhd->bgnqhd', p.astype(v.dtype), vb,
                   preferred_element_type=jnp.float32)
    o = o / den.transpose(0, 1, 2, 4, 3)[..., None]
    lse = m[..., 0] + jnp.log(den)

    o = o.reshape(b, dilation, Lp, h, hd)[:, :, :L].transpose(0, 2, 1, 3, 4).reshape(b, s, h, hd)
    lse = lse.transpose(0, 1, 2, 4, 3).reshape(b, dilation, Lp, h)[:, :, :L]
    lse = lse.transpose(0, 2, 1, 3).reshape(b, s, h)
    return o, lse


def _dilated_attention(q, k, v, rel_bias):
    results = [_dilated_pattern(q, k, v, rel_bias, w, d) for (w, d) in DILATED_PATTERNS]
    outs = jnp.stack([o for o, _ in results], axis=0)
    lses = jnp.stack([l for _, l in results], axis=0)
    wts = jax.nn.softmax(lses, axis=0)
    return jnp.einsum('pbsh,pbshd->bshd', wts, outs)


def _multiscale_pool_minus_self(u):
    b, s, g, c = u.shape
    uf = u.astype(jnp.float32)
    cs = jnp.pad(jnp.cumsum(uf, axis=1), ((0, 0), (1, 0), (0, 0), (0, 0)))
    pos = np.arange(s)
    outs = []
    for gi, w in enumerate(POOL_WINDOWS):
        lo = np.maximum(pos - w // 2, 0)
        hi = np.minimum(pos + w // 2 - 1, s - 1)
        cnt = jnp.asarray((hi - lo + 1).astype(np.float32))
        csg = cs[:, :, gi]
        mean = (csg[:, hi + 1] - csg[:, lo]) / cnt[None, :, None]
        outs.append(mean - uf[:, :, gi])
    return jnp.stack(outs, axis=2)


def _dwconv3(u, w):
    up = jnp.pad(u, ((0, 0), (1, 1), (0, 0)))
    return up[:, :-2] * w[0] + up[:, 1:-1] * w[1] + up[:, 2:] * w[2]


def _even_layer(x, rel_bias, w_in, pool_w, pool_scale, w_out):
    b, s, _ = x.shape
    hproj = x @ w_in
    q, k, v, g_a, u_b, g_b = jnp.split(
        hproj, [ATT_WIDTH, 2 * ATT_WIDTH, 3 * ATT_WIDTH, 4 * ATT_WIDTH, 4 * ATT_WIDTH + POOL_WIDTH], axis=-1)
    shp = (b, s, ATT_HEADS, ATT_HEAD_DIM)
    o_a = _dilated_attention(q.reshape(shp), k.reshape(shp), v.reshape(shp), rel_bias)
    o_a = o_a.reshape(b, s, ATT_WIDTH).astype(x.dtype) * jax.nn.silu(g_a)
    pooled = _multiscale_pool_minus_self(u_b.reshape(b, s, len(POOL_WINDOWS), POOL_GROUP))
    o_b = jnp.einsum('bsgc,gcd->bsgd', pooled.astype(x.dtype), pool_w).reshape(b, s, POOL_WIDTH)
    o_b = o_b * pool_scale * jax.nn.silu(g_b)
    return jnp.concatenate([o_a, o_b], axis=-1) @ w_out


def _odd_layer(x, w_in, conv_w, w_out):
    hproj = x @ w_in
    g_b, g_c, val, gate = jnp.split(hproj, [CONV_WIDTH, 2 * CONV_WIDTH, 3 * CONV_WIDTH], axis=-1)
    y = g_b * _dwconv3(g_c * val, conv_w) * jax.nn.silu(gate)
    return y @ w_out


def _trunk(x, rel_bias, w_in_ab, pool_w, pool_scale, w_out_ab, w_in_c, conv_w, w_out_c, ln_g, ln_b):
    for layer in range(DEPTH):
        i = layer // 2
        if layer % 2 == 0:
            f = _even_layer(x, rel_bias, w_in_ab[i], pool_w[i], pool_scale[i], w_out_ab[i])
        else:
            f = _odd_layer(x, w_in_c[i], conv_w[i], w_out_c[i])
        x = _layernorm(DN_ALPHA * x + f, ln_g[layer], ln_b[layer])
    return x


def setup_inputs(seed: int = 0) -> dict:
    key = jax.random.key(seed)
    ks = jax.random.split(key, 12)
    f32 = jnp.float32
    nrm = lambda k, shape, scale: jax.random.normal(k, shape, f32) * scale
    return {
        "x_prompt": nrm(ks[0], (BATCH, SEQ, D_MODEL), 1.0),
        "x_sample": nrm(ks[1], (DEC_BATCH, DEC_SEQ, D_MODEL), 1.0),
        "rel_bias": nrm(ks[2], (REL_BUCKETS, ATT_HEADS), 0.2),
        "w_in_ab": nrm(ks[3], (N_EVEN, D_MODEL, IN_AB), D_MODEL ** -0.5),
        "pool_w": nrm(ks[4], (N_EVEN, len(POOL_WINDOWS), POOL_GROUP, POOL_GROUP), POOL_GROUP ** -0.5),
        "pool_scale": 1.0 + nrm(ks[5], (N_EVEN, POOL_WIDTH), 0.1),
        "w_out_ab": nrm(ks[6], (N_EVEN, ATT_WIDTH + POOL_WIDTH, D_MODEL),
                         DN_BETA * (ATT_WIDTH + POOL_WIDTH) ** -0.5),
        "w_in_c": nrm(ks[7], (N_ODD, D_MODEL, IN_C), D_MODEL ** -0.5),
        "conv_w": nrm(ks[8], (N_ODD, CONV_TAPS, CONV_WIDTH), CONV_TAPS ** -0.5),
        "w_out_c": nrm(ks[9], (N_ODD, CONV_WIDTH, D_MODEL), DN_BETA * CONV_WIDTH ** -0.5),
        "ln_g": 1.0 + nrm(ks[10], (DEPTH, D_MODEL), 0.02),
        "ln_b": nrm(ks[11], (DEPTH, D_MODEL), 0.02),
    }


def reference(x_prompt, x_sample, rel_bias, w_in_ab, pool_w, pool_scale, w_out_ab,
              w_in_c, conv_w, w_out_c, ln_g, ln_b):
    y_prompt = _trunk(x_prompt, rel_bias, w_in_ab, pool_w, pool_scale, w_out_ab,
                      w_in_c, conv_w, w_out_c, ln_g, ln_b)
    y_sample = _trunk(x_sample, rel_bias, w_in_ab, pool_w, pool_scale, w_out_ab,
                      w_in_c, conv_w, w_out_c, ln_g, ln_b)
    return (y_prompt, y_sample)
```

```cpp
#include <hip/hip_runtime.h>
#include <hip/hip_cooperative_groups.h>
#include <cstdio>
#include <cstdint>
namespace cg = cooperative_groups;
#ifndef EXP
#define EXP 0
#endif

#define LAS __attribute__((address_space(3)))
typedef unsigned short bf16_t;
typedef short bf16x8 __attribute__((ext_vector_type(8)));
typedef short s16x4 __attribute__((ext_vector_type(4)));
typedef float f32x4 __attribute__((ext_vector_type(4)));
typedef float f32x2 __attribute__((ext_vector_type(2)));
typedef unsigned u32x4 __attribute__((ext_vector_type(4)));
typedef unsigned u32x2 __attribute__((ext_vector_type(2)));

constexpr int DM = 2048, MP = 8192, MS = 16384, MT = MP + MS;
constexpr int LDH = 10240;
constexpr int C_Q = 0, C_K = 2048, C_V = 4096, C_GA = 6144, C_UB = 8192, C_GB = 9216;
constexpr int LDA = 6144, LDB = 4096; constexpr size_t HEADSZ = (size_t)MT * 128, PARTSZ = (size_t)MT * 2048, WS_RB = (size_t)MT * 6144 * 2;
constexpr int A_Y0 = 0, A_Y1 = 2048, A_X1 = 4096, B_GA = 0, B_UB = 2048, B_GB = 3072;
constexpr float LOG2E = 1.4426950408889634f;
constexpr float QSCALE = 0.08838834764831845f * LOG2E;
constexpr float DN_ALPHA = 1.4142135623730951f;
constexpr float LN_EPS = 1e-5f;
constexpr int LDS_BYTES = 147456;

constexpr size_t DO_XB = 0;
constexpr size_t DO_WT1 = 100663296;
constexpr size_t DO_WT2 = DO_WT1 + 41943040;
constexpr size_t DO_WT3 = DO_WT2 + 12582912;
constexpr size_t DO_WT4 = DO_WT3 + 33554432;
constexpr size_t DO_WT5 = DO_WT4 + 8388608;
static_assert(DO_WT5 + 524288 <= (size_t)MT * DM * 4, "d_out scratch map");
constexpr size_t WS_H0 = 0, WS_BAR = (size_t)MT * LDH * 2, WS_LACC = (size_t)MT * LDH * 2 + 1048576, WS_STAT = WS_LACC + (size_t)MT * 16 * 4, WS_END = WS_STAT + (size_t)MT * 2 * 4;

typedef _Float16 h16x2 __attribute__((ext_vector_type(2)));
__device__ __forceinline__ unsigned pkh(float lo, float hi) { h16x2 v; v.x = (_Float16)lo; v.y = (_Float16)hi; return __builtin_bit_cast(unsigned, v); }
__device__ __forceinline__ float hlo(unsigned w) { return (float)__builtin_bit_cast(h16x2, w).x; }
__device__ __forceinline__ float hhi(unsigned w) { return (float)__builtin_bit_cast(h16x2, w).y; }

namespace pg8 {
constexpr int BM = 256, BK = 64, HALF = 128, HTB = HALF * BK * 2, STAGE_BYTES = 8 * HTB, NXCD = 8, WGM = 8;
__host__ __device__ __forceinline__ int lds_byte(int r, int c) { const int st = (r >> 4) * 2 + (c >> 5), rr = r & 15, cc = c & 31, ob = rr * 64 + cc * 2; return st * 1024 + (ob ^ (((ob >> 9) & 1) << 5)); }
__host__ __device__ __forceinline__ void stage_rc(int b, int& R, int& C) { const int st = b / 1024, sb = b % 1024, swz = sb ^ (((sb >> 9) & 1) << 5); R = (st >> 1) * 16 + swz / 64; C = (st & 1) * 32 + (swz % 64) / 2; }
__host__ __device__ __forceinline__ int perm32(int rho) { const int n = rho >> 4, i = rho & 15; return 8 * (i >> 2) + 4 * n + (i & 3); }

struct Unit { int pm, pn; };
struct Gemm { const bf16_t* A; const bf16_t* Bt; int M, N, K, lda, ldb, a_pn_off, tsplit, ajump; };

struct StaticOrder {
    int nM, nN, nwg, G, c;
    __host__ __device__ void init(int M, int N, int G_, int c_) { nM = M / BM; nN = N / BM; nwg = nM * nN; G = G_; c = c_; }
    __host__ __device__ bool next(int i, Unit& u) const {
        const long L = (long)i * G + c; if (L >= nwg) return false;
        int wgid = (int)L; { const int q = nwg / NXCD, r = nwg % NXCD, xcd = wgid % NXCD, off = wgid / NXCD; wgid = (xcd < r ? xcd * (q + 1) : r * (q + 1) + (xcd - r) * q) + off; }
        const int nig = WGM * nN, gid = wgid / nig, fm = gid * WGM, gsz = (nM - fm) < WGM ? (nM - fm) : WGM;
        u.pm = fm + ((wgid % nig) % gsz); u.pn = (wgid % nig) / gsz; return true;
    }
};

__device__ __forceinline__ unsigned cvt_pk_bf16(float lo, float hi) { unsigned r; asm volatile("v_cvt_pk_bf16_f32 %0, %1, %2" : "=v"(r) : "v"(lo), "v"(hi)); return r; }
__device__ __forceinline__ float silu_f(float x) { return x * __builtin_amdgcn_rcpf(1.0f + __builtin_amdgcn_exp2f(-x * LOG2E)); }

struct EpiBf16 {
    static constexpr bool PERM = true;
    bf16_t* O; int ldc; int split_cols; float scale0;
    __device__ __forceinline__ void operator()(const f32x4 (&acc)[2][2][4][2], const Unit& u, int wr, int wc, int fr, int fq) const {
        const int row0 = u.pm * BM + wr * 64 + fr; const int colt = u.pn * BM;
        float sc = 1.f; if (split_cols) { if (colt < split_cols) sc = scale0; }
        const int col0 = colt + wc * 32 + 8 * fq;
#pragma unroll
        for (int ai = 0; ai < 2; ++ai)
#pragma unroll
            for (int m = 0; m < 4; ++m) { bf16_t* rowp = O + (size_t)(row0 + ai * HALF + m * 16) * ldc + col0;
#pragma unroll
                for (int bj = 0; bj < 2; ++bj) { f32x4 v0 = acc[ai][bj][m][0] * sc, v1 = acc[ai][bj][m][1] * sc;
                    u32x4 w; w.x = cvt_pk_bf16(v0[0], v0[1]); w.y = cvt_pk_bf16(v0[2], v0[3]); w.z = cvt_pk_bf16(v1[0], v1[1]); w.w = cvt_pk_bf16(v1[2], v1[3]);
                    *(u32x4*)(rowp + bj * HALF) = w; } }
    }
};
struct EpiHead {
    static constexpr bool PERM = true;
    bf16_t* RA; float scale0;
    __device__ __forceinline__ void operator()(const f32x4 (&acc)[2][2][4][2], const Unit& u, int wr, int wc, int fr, int fq) const {
        const int row0 = u.pm * BM + wr * 64 + fr; const int colt = u.pn * BM;
        const float sc = colt < 2048 ? scale0 : 1.f;
        bf16_t* base = RA + (size_t)(colt >> 7) * HEADSZ + (size_t)row0 * 128 + wc * 32 + 8 * fq;
#pragma unroll
        for (int ai = 0; ai < 2; ++ai)
#pragma unroll
            for (int m = 0; m < 4; ++m) { bf16_t* rowp = base + (ai * HALF + m * 16) * 128;
#pragma unroll
                for (int bj = 0; bj < 2; ++bj) { f32x4 v0 = acc[ai][bj][m][0] * sc, v1 = acc[ai][bj][m][1] * sc;
                    u32x4 w; w.x = cvt_pk_bf16(v0[0], v0[1]); w.y = cvt_pk_bf16(v0[2], v0[3]); w.z = cvt_pk_bf16(v1[0], v1[1]); w.w = cvt_pk_bf16(v1[2], v1[3]);
                    *(u32x4*)(rowp + bj * HEADSZ) = w; } }
    }
};
__device__ __forceinline__ float bfl(unsigned w) { return __builtin_bit_cast(float, w << 16); }
__device__ __forceinline__ float bfh(unsigned w) { return __builtin_bit_cast(float, w & 0xffff0000u); }
struct EpiResBf {
    static constexpr bool PERM = true;
    const float* res0; const float* res1; int split_row; int ldr; bf16_t* out; int ldo; float alpha;
    __device__ __forceinline__ void operator()(const f32x4 (&acc)[2][2][4][2], const Unit& u, int wr, int wc, int fr, int fq) const {
        const int col0 = u.pn * BM + wc * 32 + 8 * fq;
#pragma unroll
        for (int am = 0; am < 4; ++am) { const int ai = am >> 1, m0 = (am & 1) * 2;
            f32x4 r[2][2][2];
#pragma unroll
            for (int mm = 0; mm < 2; ++mm) { const int m = m0 + mm; const int row = u.pm * BM + ai * HALF + wr * 64 + m * 16 + fr;
                const float* rp = (row < split_row ? res0 + (size_t)row * ldr : res1 + (size_t)(row - split_row) * ldr) + col0;
#pragma unroll
                for (int bj = 0; bj < 2; ++bj) { r[mm][bj][0] = *(const f32x4*)(rp + bj * HALF); r[mm][bj][1] = *(const f32x4*)(rp + bj * HALF + 4); } }
            asm volatile("" ::: "memory"); __builtin_amdgcn_sched_barrier(0);
#pragma unroll
            for (int mm = 0; mm < 2; ++mm) { const int m = m0 + mm; const int row = u.pm * BM + ai * HALF + wr * 64 + m * 16 + fr;
                bf16_t* op = out + (size_t)row * ldo + col0;
#pragma unroll
                for (int bj = 0; bj < 2; ++bj) { const f32x4 y0 = r[mm][bj][0] * alpha + acc[ai][bj][m][0], y1 = r[mm][bj][1] * alpha + acc[ai][bj][m][1];
                    u32x4 w; w.x = pkh(y0[0], y0[1]); w.y = pkh(y0[2], y0[3]); w.z = pkh(y1[0], y1[1]); w.w = pkh(y1[2], y1[3]);
                    *(u32x4*)(op + bj * HALF) = w; } }
            asm volatile("" ::: "memory"); __builtin_amdgcn_sched_barrier(0);
        }
    }
};
struct EpiResLnBf {
    static constexpr bool PERM = true;
    const bf16_t* y; int ldy; const float* stats; const float* gam; const float* bet; bf16_t* out; int ldo; float alpha;
    __device__ __forceinline__ void operator()(const f32x4 (&acc)[2][2][4][2], const Unit& u, int wr, int wc, int fr, int fq) const {
        const int col0 = u.pn * BM + wc * 32 + 8 * fq;
        f32x4 gg[2][2], bb[2][2];
#pragma unroll
        for (int bj = 0; bj < 2; ++bj)
#pragma unroll
            for (int n = 0; n < 2; ++n) { gg[bj][n] = *(const f32x4*)(gam + col0 + bj * HALF + n * 4) * alpha; bb[bj][n] = *(const f32x4*)(bet + col0 + bj * HALF + n * 4) * alpha; }
#pragma unroll
        for (int ai = 0; ai < 2; ++ai) {
            u32x4 yv[4][2]; f32x2 st[4];
#pragma unroll
            for (int m = 0; m < 4; ++m) { const int row = u.pm * BM + ai * HALF + wr * 64 + m * 16 + fr;
                st[m] = *(const f32x2*)(stats + (size_t)row * 2);
                const bf16_t* yp = y + (size_t)row * ldy + col0;
#pragma unroll
                for (int bj = 0; bj < 2; ++bj) yv[m][bj] = *(const u32x4*)(yp + bj * HALF); }
            asm volatile("" ::: "memory"); __builtin_amdgcn_sched_barrier(0);
#pragma unroll
            for (int m = 0; m < 4; ++m) { const int row = u.pm * BM + ai * HALF + wr * 64 + m * 16 + fr;
                bf16_t* op = out + (size_t)row * ldo + col0;
#pragma unroll
                for (int bj = 0; bj < 2; ++bj) { const u32x4 v = yv[m][bj];
                    const f32x4 r0 = (f32x4){hlo(v.x), hhi(v.x), hlo(v.y), hhi(v.y)}, r1 = (f32x4){hlo(v.z), hhi(v.z), hlo(v.w), hhi(v.w)};
                    const f32x4 y0 = (r0 - st[m].x) * st[m].y * gg[bj][0] + bb[bj][0] + acc[ai][bj][m][0], y1 = (r1 - st[m].x) * st[m].y * gg[bj][1] + bb[bj][1] + acc[ai][bj][m][1];
                    u32x4 w; w.x = pkh(y0[0], y0[1]); w.y = pkh(y0[2], y0[3]); w.z = pkh(y1[0], y1[1]); w.w = pkh(y1[2], y1[3]);
                    *(u32x4*)(op + bj * HALF) = w; } }
            asm volatile("" ::: "memory"); __builtin_amdgcn_sched_barrier(0);
        }
    }
};
struct EpiRes {
    static constexpr bool PERM = false;
    const float* res0; const float* res1; int split_row; int ldr; float* out; int ldo; float alpha;
    __device__ __forceinline__ void operator()(const f32x4 (&acc)[2][2][4][2], const Unit& u, int wr, int wc, int fr, int fq) const {
        const int col0 = u.pn * BM + wc * 32 + 4 * fq;
#pragma unroll
        for (int ai = 0; ai < 2; ++ai)
#pragma unroll
            for (int m = 0; m < 4; ++m) { const int row = u.pm * BM + ai * HALF + wr * 64 + m * 16 + fr;
                const float* rp = (row < split_row ? res0 + (size_t)row * ldr : res1 + (size_t)(row - split_row) * ldr) + col0;
                float* op = out + (size_t)row * ldo + col0;
#pragma unroll
                for (int bj = 0; bj < 2; ++bj)
#pragma unroll
                    for (int n = 0; n < 2; ++n) { const f32x4 r = *(const f32x4*)(rp + bj * HALF + n * 16); *(f32x4*)(op + bj * HALF + n * 16) = r * alpha + acc[ai][bj][m][n]; } }
    }
};
struct EpiResLn {
    static constexpr bool PERM = false;
    float* y; int ld; const float* stats; const float* gam; const float* bet; float alpha;
    __device__ __forceinline__ void operator()(const f32x4 (&acc)[2][2][4][2], const Unit& u, int wr, int wc, int fr, int fq) const {
        const int col0 = u.pn * BM + wc * 32 + 4 * fq;
        f32x4 gg[2][2], bb[2][2];
#pragma unroll
        for (int bj = 0; bj < 2; ++bj)
#pragma unroll
            for (int n = 0; n < 2; ++n) { gg[bj][n] = *(const f32x4*)(gam + col0 + bj * HALF + n * 16) * alpha; bb[bj][n] = *(const f32x4*)(bet + col0 + bj * HALF + n * 16) * alpha; }
#pragma unroll
        for (int ai = 0; ai < 2; ++ai)
#pragma unroll
            for (int m = 0; m < 4; ++m) { const int row = u.pm * BM + ai * HALF + wr * 64 + m * 16 + fr;
                const f32x2 st = *(const f32x2*)(stats + (size_t)row * 2);
                float* op = y + (size_t)row * ld + col0;
#pragma unroll
                for (int bj = 0; bj < 2; ++bj)
#pragma unroll
                    for (int n = 0; n < 2; ++n) { const f32x4 r = *(const f32x4*)(op + bj * HALF + n * 16); *(f32x4*)(op + bj * HALF + n * 16) = (r - st.x) * st.y * gg[bj][n] + bb[bj][n] + acc[ai][bj][m][n]; } }
    }
};
struct EpiPair {
    static constexpr bool PERM = true;
    bf16_t* Z; bf16_t* W; int ldc;
    __device__ __forceinline__ void operator()(const f32x4 (&acc)[2][2][4][2], const Unit& u, int wr, int wc, int fr, int fq) const {
        const int type = u.pn & 1, cb = u.pn >> 1; bf16_t* dst = type ? W : Z;
        const int col0 = cb * 128 + wc * 32 + 8 * fq;
#pragma unroll
        for (int ai = 0; ai < 2; ++ai)
#pragma unroll
            for (int m = 0; m < 4; ++m) { const int row = u.pm * BM + ai * HALF + wr * 64 + m * 16 + fr;
                f32x4 a0 = acc[ai][0][m][0], a1 = acc[ai][0][m][1], b0 = acc[ai][1][m][0], b1 = acc[ai][1][m][1];
                if (type) {
#pragma unroll
                    for (int j = 0; j < 4; ++j) { b0[j] = silu_f(b0[j]); b1[j] = silu_f(b1[j]); } }
                a0 = a0 * b0; a1 = a1 * b1;
                u32x4 w; w.x = cvt_pk_bf16(a0[0], a0[1]); w.y = cvt_pk_bf16(a0[2], a0[3]); w.z = cvt_pk_bf16(a1[0], a1[1]); w.w = cvt_pk_bf16(a1[2], a1[3]);
                *(u32x4*)(dst + (size_t)row * ldc + col0) = w; }
    }
};

template <class Epi, bool ALIGN_EPI = true>
__device__ __forceinline__ void gemm_phase(LAS unsigned char* lds, const Gemm g, const StaticOrder& S, const Epi& E) {
    const int tid = threadIdx.x, wid = __builtin_amdgcn_readfirstlane(tid >> 6), lane = tid & 63, wr = wid >> 2, wc = wid & 3, fr = lane & 15, fq = lane >> 4;
    const int K = g.K, nt = K / BK;
    unsigned voffA[2], voffB[2];
#pragma unroll
    for (int i = 0; i < 2; ++i) { int R, C; stage_rc(tid * 16 + i * 8192, R, C); const int Rb = Epi::PERM ? ((R & ~31) + perm32(R & 31)) : R;
        voffA[i] = (unsigned)(R * g.lda + C) * 2u; voffB[i] = (unsigned)(Rb * g.ldb + C) * 2u; }
    const size_t kstep = (size_t)(BK * 2);
    const size_t hstepA = (size_t)HALF * g.lda * 2, hstepB = (size_t)HALF * g.ldb * 2;
    const size_t tstepA = 2 * hstepA, tstepB = 2 * hstepB;
    const int tsplit = g.tsplit; const size_t ajump = (size_t)g.ajump;
    const unsigned ldsw = (unsigned)wid * 1024u;
    const int aoff = lds_byte(wr * 64 + fr, fq * 8), boff = lds_byte(wc * 32 + fr, fq * 8);
#define PG8_AK(base, ti) ((base) + (size_t)(ti) * kstep + (((ti) >= tsplit) ? ajump : (size_t)0))
#define PG8_SA(b, h) (((b) * 2 + (h)) * HTB)
#define PG8_SB(b, h) ((4 + (b) * 2 + (h)) * HTB)
#define PG8_STAGE(bufoff, gbase, voff) do { _Pragma("unroll") for (int _i = 0; _i < 2; ++_i) \
        __builtin_amdgcn_global_load_lds((const unsigned*)((const char*)(gbase) + (voff)[_i]), (LAS unsigned*)(lds + (bufoff) + ldsw + _i * 8192), 16, 0, 0); } while (0)
#define PG8_LDA(dst, b, h) do { _Pragma("unroll") for (int m = 0; m < 4; ++m) _Pragma("unroll") for (int k = 0; k < 2; ++k) dst[m][k] = *(const LAS bf16x8*)(lds + PG8_SA(b, h) + aoff + m * 2048 + k * 1024); } while (0)
#define PG8_LDB(dst, b, h) do { _Pragma("unroll") for (int n = 0; n < 2; ++n) _Pragma("unroll") for (int k = 0; k < 2; ++k) dst[n][k] = *(const LAS bf16x8*)(lds + PG8_SB(b, h) + boff + n * 2048 + k * 1024); } while (0)
#define PG8_MMA(ai, bj, At, Bt) do { __builtin_amdgcn_s_setprio(1); _Pragma("unroll") for (int m = 0; m < 4; ++m) _Pragma("unroll") for (int n = 0; n < 2; ++n) _Pragma("unroll") for (int k = 0; k < 2; ++k) \
        acc[ai][bj][m][n] = __builtin_amdgcn_mfma_f32_16x16x32_bf16(Bt[n][k], At[m][k], acc[ai][bj][m][n], 0, 0, 0); __builtin_amdgcn_s_setprio(0); } while (0)
#define PG8_WAIT_V(n) asm volatile("s_waitcnt vmcnt(" #n ")" ::: "memory")
#define PG8_WAIT_L(n) asm volatile("s_waitcnt lgkmcnt(" #n ")" ::: "memory")
#define PG8_BAR __builtin_amdgcn_s_barrier()
#define PG8_SCHED __builtin_amdgcn_sched_barrier(0)
    Unit cur, nxt; int ui = 0;
    if (!S.next(0, cur)) return;
    f32x4 acc[2][2][4][2];
#pragma unroll
    for (int a = 0; a < 2; ++a)
#pragma unroll
        for (int b = 0; b < 2; ++b)
#pragma unroll
            for (int m = 0; m < 4; ++m)
#pragma unroll
                for (int n = 0; n < 2; ++n) acc[a][b][m][n] = (f32x4){0.f, 0.f, 0.f, 0.f};
    bf16x8 At[4][2], B0[2][2], B1[2][2];
    const char* cA = (const char*)g.A + (size_t)cur.pm * tstepA + (size_t)cur.pn * g.a_pn_off * 2; const char* cB = (const char*)g.Bt + (size_t)cur.pn * tstepB;
    PG8_STAGE(PG8_SB(0, 0), cB, voffB); PG8_STAGE(PG8_SB(0, 1), cB + hstepB, voffB); PG8_STAGE(PG8_SA(0, 0), cA, voffA); PG8_STAGE(PG8_SA(0, 1), cA + hstepA, voffA);
    if (wr == 1) PG8_BAR;
    PG8_WAIT_V(2); PG8_BAR;
    PG8_STAGE(PG8_SB(1, 0), cB + kstep, voffB); PG8_STAGE(PG8_SA(1, 0), cA + kstep, voffA); PG8_STAGE(PG8_SB(1, 1), cB + hstepB + kstep, voffB);
    PG8_WAIT_V(6); PG8_BAR;
    for (;;) {
        const bool has_next = S.next(ui + 1, nxt);
        const char* nA = has_next ? (const char*)g.A + (size_t)nxt.pm * tstepA + (size_t)nxt.pn * g.a_pn_off * 2 : cA; const char* nB = has_next ? (const char*)g.Bt + (size_t)nxt.pn * tstepB : cB;
        for (int t = 0; t < nt; t += 2) {
            const bool last = (t == nt - 2);
            const char* a1 = PG8_AK(cA, t + 1);
            const char* a2 = last ? nA : PG8_AK(cA, t + 2); const char* b2 = last ? nB : cB + (size_t)(t + 2) * kstep;
            const char* a3 = last ? nA + kstep : PG8_AK(cA, t + 3); const char* b3 = b2 + kstep;
            PG8_LDB(B0, 0, 0); PG8_LDB(B1, 0, 1); PG8_SCHED; PG8_LDA(At, 0, 0); PG8_STAGE(PG8_SA(1, 1), a1 + hstepA, voffA);
            PG8_WAIT_V(8); PG8_WAIT_L(0); PG8_BAR; PG8_MMA(0, 0, At, B0); PG8_MMA(0, 1, At, B1); PG8_BAR; PG8_SCHED;
            PG8_LDA(At, 0, 1); PG8_STAGE(PG8_SB(0, 0), b2, voffB); PG8_STAGE(PG8_SB(0, 1), b2 + hstepB, voffB); PG8_STAGE(PG8_SA(0, 0), a2, voffA);
            PG8_WAIT_V(8); PG8_WAIT_L(0); PG8_BAR; PG8_MMA(1, 0, At, B0); PG8_MMA(1, 1, At, B1); PG8_BAR; PG8_SCHED;
            PG8_LDB(B0, 1, 0); PG8_LDB(B1, 1, 1); PG8_SCHED; PG8_LDA(At, 1, 0); PG8_STAGE(PG8_SA(0, 1), a2 + hstepA, voffA);
            PG8_WAIT_V(8); PG8_WAIT_L(0); PG8_BAR; PG8_MMA(0, 0, At, B0); PG8_MMA(0, 1, At, B1); PG8_BAR; PG8_SCHED;
            PG8_LDA(At, 1, 1); PG8_STAGE(PG8_SB(1, 0), b3, voffB); PG8_STAGE(PG8_SB(1, 1), b3 + hstepB, voffB); PG8_STAGE(PG8_SA(1, 0), a3, voffA);
            PG8_WAIT_V(8); PG8_WAIT_L(0); PG8_BAR; PG8_MMA(1, 0, At, B0); PG8_MMA(1, 1, At, B1); PG8_BAR; PG8_SCHED;
        }
        if constexpr (ALIGN_EPI) { if (wr == 0) PG8_BAR; }
        E(acc, cur, wr, wc, fr, fq);
        if (!has_next) break;
#pragma unroll
        for (int a = 0; a < 2; ++a)
#pragma unroll
            for (int b = 0; b < 2; ++b)
#pragma unroll
                for (int m = 0; m < 4; ++m)
#pragma unroll
                    for (int n = 0; n < 2; ++n) acc[a][b][m][n] = (f32x4){0.f, 0.f, 0.f, 0.f};
        cur = nxt; cA = nA; cB = nB; ++ui;
        if constexpr (ALIGN_EPI) { if (wr == 1) PG8_BAR; }
    }
    PG8_WAIT_V(0);
    if constexpr (!ALIGN_EPI) { if (wr == 0) PG8_BAR; }
    PG8_BAR;
#undef PG8_AK
#undef PG8_SA
#undef PG8_SB
#undef PG8_STAGE
#undef PG8_LDA
#undef PG8_LDB
#undef PG8_MMA
#undef PG8_WAIT_V
#undef PG8_WAIT_L
#undef PG8_BAR
#undef PG8_SCHED
}
}

__device__ __forceinline__ unsigned f2bf(float f) { unsigned u = __builtin_bit_cast(unsigned, f); return (u + 0x7fffu + ((u >> 16) & 1u)) >> 16; }
__device__ __forceinline__ unsigned pk2(float lo, float hi) { return f2bf(lo) | (f2bf(hi) << 16); }
__device__ __forceinline__ float bf_lo(unsigned w) { return __builtin_bit_cast(float, w << 16); }
__device__ __forceinline__ float bf_hi(unsigned w) { return __builtin_bit_cast(float, w & 0xffff0000u); }
__device__ __forceinline__ float wave_sum(float v) {
#pragma unroll
    for (int o = 1; o < 64; o <<= 1) v += __shfl_xor(v, o);
    return v;
}
__device__ __forceinline__ int t5_bucket(int rel) {
    const int n = rel < 0 ? -rel : rel; const int b = rel > 0 ? 16 : 0;
    const int v = n < 8 ? n : 8 + (n >= 15) + (n >= 27) + (n >= 50) + (n >= 91) + (n >= 166) + (n >= 305) + (n >= 559);
    return b + v;
}

__device__ __forceinline__ void transpose_item(const float* W, int N, int k0, int n0, bf16_t* WT, int ldt, int drow0, LAS float* scr, int lane) {
    float wv[32];
#pragma unroll
    for (int i = 0; i < 32; ++i) { const int kk = 2 * i + (lane >> 5); wv[i] = W[(size_t)(k0 + kk) * N + n0 + (lane & 31)]; }
#pragma unroll
    for (int i = 0; i < 32; ++i) { const int kk = 2 * i + (lane >> 5); scr[kk * 33 + (lane & 31)] = wv[i]; }
    asm volatile("s_waitcnt lgkmcnt(0)" ::: "memory");
    const int c = lane & 7;
#pragma unroll
    for (int j = 0; j < 4; ++j) { const int n = (lane >> 3) + 8 * j; const LAS float* s = scr + (8 * c) * 33 + n;
        u32x4 o; o.x = pk2(s[0 * 33], s[1 * 33]); o.y = pk2(s[2 * 33], s[3 * 33]); o.z = pk2(s[4 * 33], s[5 * 33]); o.w = pk2(s[6 * 33], s[7 * 33]);
        *(u32x4*)(WT + (size_t)(drow0 + n) * ldt + k0 + 8 * c) = o; }
    asm volatile("s_waitcnt lgkmcnt(0)" ::: "memory");
}

typedef short v4i16_t __attribute__((ext_vector_type(4)));
__device__ __forceinline__ s16x4 vtr(LAS const unsigned char* p) { return __builtin_bit_cast(s16x4, __builtin_amdgcn_ds_read_tr16_b64_v4i16((LAS v4i16_t*)p)); }

template <int PASS, bool SB = false>
__device__ __forceinline__ void attn_pass(LAS unsigned char* lds, bf16_t* RA, bf16_t* RB, bf16_t* OACC, float* LACC, const float* rel_bias, const int sb_seq = 0, const int sb_S = 0, const int sb_blk = 0, const int sb_h = 0) {
    constexpr int D = PASS == 0 ? 1 : (PASS == 1 ? 4 : 16);
    constexpr int KOFF = 0, VOFF = 69632, BOFF = 143360, PITCH = 272, VPITCH = 288;
    const int tid = threadIdx.x, lane = tid & 63, w = __builtin_amdgcn_readfirstlane(tid >> 6), fr = lane & 15, fq = lane >> 4;
    const int G = gridDim.x;
    LAS float* bias = (LAS float*)(lds + BOFF);
    const int ch = tid & 15, r0 = tid >> 4;
#define ATT_DECODE(IT) int seq_base, S_, g, qb, h; \
        if (SB) { h = sb_h; seq_base = sb_seq; S_ = sb_S; if (PASS == 0) { g = 0; qb = 4 * sb_blk + (IT); } else { g = (IT); qb = sb_blk; } } \
        else { const int c_ = (IT) >> 4; h = (IT) & 15; int cc_; if (c_ < 64) { seq_base = (c_ >> 4) * 2048; S_ = 2048; cc_ = c_ & 15; } else { seq_base = MP; S_ = 16384; cc_ = c_ - 64; } \
            const int nqb_ = (S_ / D) >> 7; g = cc_ / nqb_; qb = cc_ - g * nqb_; } \
        const int L = S_ / D, kj0 = qb * 128 - 64;
    u32x4 kv[8], vv[8]; bf16x8 qn[4];
#define ATT_LOAD() do { \
        _Pragma("unroll") for (int i = 0; i < 8; ++i) { int kj = kj0 + r0 + 32 * i; kj = kj < 0 ? 0 : (kj > L - 1 ? L - 1 : kj); \
            const unsigned off_ = (unsigned)(h * MT + seq_base + kj * D + g) * 256u + (unsigned)ch * 16u;        \
            kv[i] = *(const u32x4*)((const char*)(RA + PARTSZ) + off_); vv[i] = *(const u32x4*)((const char*)(RA + 2 * PARTSZ) + off_); } \
        const int qrow_ = seq_base + (qb * 128 + 16 * w + fr) * D + g; \
        _Pragma("unroll") for (int kk = 0; kk < 4; ++kk) qn[kk] = *(const bf16x8*)((const char*)RA + ((unsigned)(h * MT + qrow_) * 256u + (unsigned)(kk * 64 + fq * 16))); } while (0)
    int item = SB ? 0 : (int)blockIdx.x; const int item_end = SB ? 4 : 3072, item_step = SB ? 1 : G;
    const bool hoist = SB || (G & 15) == 0;
    if (hoist && tid < 200) { const int bi = tid - 32; bias[tid] = (bi >= 0 && bi <= 128) ? rel_bias[t5_bucket((bi - 64) * D) * 16 + (SB ? sb_h : (item & 15))] * LOG2E : -1.0e30f; }
    if (item < item_end) { ATT_DECODE(item) ATT_LOAD(); }
    for (; item < item_end; item += item_step) {
        ATT_DECODE(item)
#pragma unroll
        for (int i = 0; i < 8; ++i) { const int r = r0 + 32 * i;
            *(LAS u32x4*)(lds + KOFF + r * PITCH + ch * 16) = kv[i]; *(LAS u32x4*)(lds + VOFF + r * VPITCH + ch * 16) = vv[i]; }
        if (!hoist) { if (tid < 200) { const int bi = tid - 32; bias[tid] = (bi >= 0 && bi <= 128) ? rel_bias[t5_bucket((bi - 64) * D) * 16 + h] * LOG2E : -1.0e30f; } }
        bf16x8 qf[4];
#pragma unroll
        for (int kk = 0; kk < 4; ++kk) qf[kk] = qn[kk];
        const int qrow = seq_base + (qb * 128 + 16 * w + fr) * D + g;
        asm volatile("s_waitcnt lgkmcnt(0)\n\ts_barrier" ::: "memory");
        if (item + item_step < item_end) { const int nit = item + item_step; ATT_DECODE(nit) ATT_LOAD(); }
        const int ts = w & ~1;
        f32x4 s[10];
        {
            LAS const unsigned char* kptr = lds + KOFF + (16 * ts + fr) * PITCH + fq * 16;
            bf16x8 kf[2][2][4];
#define ATT_LDK(BUF, TP) _Pragma("unroll") for (int u = 0; u < 2; ++u) _Pragma("unroll") for (int kk = 0; kk < 4; ++kk) kf[BUF][u][kk] = *(const LAS bf16x8*)(kptr + (16 * (2 * (TP) + u)) * PITCH + kk * 64);
            ATT_LDK(0, 0)
#pragma unroll
            for (int tp = 0; tp < 5; ++tp) {
                if (tp + 1 < 5) { ATT_LDK((tp + 1) & 1, tp + 1) }
                __builtin_amdgcn_sched_barrier(0);
                s[2 * tp] = (f32x4){0.f, 0.f, 0.f, 0.f}; s[2 * tp + 1] = (f32x4){0.f, 0.f, 0.f, 0.f};
                if (tp == 0 && (w & 1)) {
#pragma unroll
                    for (int kk = 0; kk < 4; ++kk) s[1] = __builtin_amdgcn_mfma_f32_16x16x32_bf16(kf[0][1][kk], qf[kk], s[1], 0, 0, 0);
                } else if (tp == 4 && !(w & 1)) {
#pragma unroll
                    for (int kk = 0; kk < 4; ++kk) s[8] = __builtin_amdgcn_mfma_f32_16x16x32_bf16(kf[0][0][kk], qf[kk], s[8], 0, 0, 0);
                } else {
#pragma unroll
                for (int kk = 0; kk < 4; ++kk) { s[2 * tp] = __builtin_amdgcn_mfma_f32_16x16x32_bf16(kf[tp & 1][0][kk], qf[kk], s[2 * tp], 0, 0, 0);
                    s[2 * tp + 1] = __builtin_amdgcn_mfma_f32_16x16x32_bf16(kf[tp & 1][1][kk], qf[kk], s[2 * tp + 1], 0, 0, 0); } }
                __builtin_amdgcn_sched_barrier(0);
            }
#undef ATT_LDK
        }
        const int kb = 16 * ts + 4 * fq;
        LAS const float* bl = bias + (kb - (16 * w + fr) + 32);
        float mx = -3.0e38f;
        if (kj0 >= 0 && kj0 + 255 < L) {
#pragma unroll
            for (int t = 0; t < 10; ++t)
#pragma unroll
                for (int i = 0; i < 4; ++i) { const float v = s[t][i] + bl[16 * t + i]; s[t][i] = v; mx = fmaxf(mx, v); }
        } else {
#pragma unroll
            for (int t = 0; t < 10; ++t)
#pragma unroll
                for (int i = 0; i < 4; ++i) { const int kj = kj0 + kb + 16 * t + i;
                    const float v = ((unsigned)kj < (unsigned)L) ? s[t][i] + bl[16 * t + i] : -1.0e30f; s[t][i] = v; mx = fmaxf(mx, v); }
        }
        mx = fmaxf(mx, __shfl_xor(mx, 16)); mx = fmaxf(mx, __shfl_xor(mx, 32));
        float l = 0.f;
#pragma unroll
        for (int t = 0; t < 10; ++t)
#pragma unroll
            for (int i = 0; i < 4; ++i) { const float p = __builtin_amdgcn_exp2f(s[t][i] - mx); s[t][i] = p; l += p; }
        l += __shfl_xor(l, 16); l += __shfl_xor(l, 32);
        bf16x8 pf[5];
#pragma unroll
        for (int b = 0; b < 5; ++b) { u32x4 u; u.x = pg8::cvt_pk_bf16(s[2 * b][0], s[2 * b][1]); u.y = pg8::cvt_pk_bf16(s[2 * b][2], s[2 * b][3]);
            u.z = pg8::cvt_pk_bf16(s[2 * b + 1][0], s[2 * b + 1][1]); u.w = pg8::cvt_pk_bf16(s[2 * b + 1][2], s[2 * b + 1][3]); pf[b] = __builtin_bit_cast(bf16x8, u); }
        float Lp = 0.f; u32x2 pv[8]; u32x2 gv[8];
        if (PASS > 0) { Lp = LACC[(size_t)qrow * 16 + h];
#pragma unroll
            for (int db = 0; db < 8; ++db) pv[db] = *(const u32x2*)((const char*)OACC + ((unsigned)(h * MT + qrow) * 256u + (unsigned)(32 * db + 8 * fq))); }
        if (PASS == 2) {
#pragma unroll
            for (int db = 0; db < 8; ++db) gv[db] = *(const u32x2*)((const char*)RB + ((unsigned)qrow * (unsigned)(LDB * 2) + (unsigned)(h * 256 + 32 * db + 8 * fq))); }
        f32x4 o[8];
        const int q4 = (lane & 15) >> 2, p4 = lane & 3;
        LAS const unsigned char* vbase = lds + VOFF + (16 * ts + 4 * fq + q4) * VPITCH + p4 * 8;
        {
            s16x4 vl[2][5], vh[2][5];
#define ATT_LDV(BUF, DB) _Pragma("unroll") for (int b = 0; b < 5; ++b) { vl[BUF][b] = vtr(vbase + (32 * b) * VPITCH + (DB) * 32); vh[BUF][b] = vtr(vbase + (32 * b + 16) * VPITCH + (DB) * 32); }
            ATT_LDV(0, 0)
#pragma unroll
            for (int db = 0; db < 8; ++db) {
                if (db + 1 < 8) { ATT_LDV((db + 1) & 1, db + 1) }
                __builtin_amdgcn_sched_barrier(0);
                o[db] = (f32x4){0.f, 0.f, 0.f, 0.f};
#pragma unroll
                for (int b = 0; b < 5; ++b) { const s16x4 lo = vl[db & 1][b], hi = vh[db & 1][b];
                    const bf16x8 vf = (bf16x8){lo[0], lo[1], lo[2], lo[3], hi[0], hi[1], hi[2], hi[3]};
                    o[db] = __builtin_amdgcn_mfma_f32_16x16x32_bf16(vf, pf[b], o[db], 0, 0, 0); }
                __builtin_amdgcn_sched_barrier(0);
            }
#undef ATT_LDV
        }
        const float rl = 1.0f / l;
        float Lc = mx + __builtin_amdgcn_logf(l);
        float wb = rl, wa = 0.f;
        if (PASS > 0) { const float Lm = fmaxf(Lp, Lc);
            const float ea = __builtin_amdgcn_exp2f(Lp - Lm), eb = __builtin_amdgcn_exp2f(Lc - Lm), den = ea + eb, rd = 1.0f / den;
            wa = ea * rd; wb = eb * rd * rl; Lc = Lm + __builtin_amdgcn_logf(den); }
        if (PASS < 2) { if (fq == 0) LACC[(size_t)qrow * 16 + h] = Lc; }
#pragma unroll
        for (int db = 0; db < 8; ++db) { f32x4 v = o[db] * wb;
            const size_t ocol = (size_t)h * 128 + 16 * db + 4 * fq;
            if (PASS > 0) { v[0] += wa * bf_lo(pv[db].x); v[1] += wa * bf_hi(pv[db].x); v[2] += wa * bf_lo(pv[db].y); v[3] += wa * bf_hi(pv[db].y); }
            if (PASS < 2) { u32x2 ov; ov.x = pg8::cvt_pk_bf16(v[0], v[1]); ov.y = pg8::cvt_pk_bf16(v[2], v[3]); *(u32x2*)((char*)OACC + ((unsigned)(h * MT + qrow) * 256u + (unsigned)(32 * db + 8 * fq))) = ov; }
            else { v[0] *= pg8::silu_f(bf_lo(gv[db].x)); v[1] *= pg8::silu_f(bf_hi(gv[db].x)); v[2] *= pg8::silu_f(bf_lo(gv[db].y)); v[3] *= pg8::silu_f(bf_hi(gv[db].y));
                u32x2 ov; ov.x = pg8::cvt_pk_bf16(v[0], v[1]); ov.y = pg8::cvt_pk_bf16(v[2], v[3]); *(u32x2*)((char*)RB + ((unsigned)qrow * (unsigned)(LDB * 2) + (unsigned)(h * 256 + 32 * db + 8 * fq))) = ov; } }
        asm volatile("s_waitcnt lgkmcnt(0)\n\ts_barrier" ::: "memory");
    }
#undef ATT_DECODE
#undef ATT_LOAD
}

#define XB_TMO      128
#define XB_XCNT(j)  (256  + 64 * (j))
#define XB_XSUB(j)  (1280 + 64 * (j))
#define XB_XGEN(j)  (2304 + 64 * (j))
#define XB_TOP      3328
#define XB_TOPGEN   3392
#define XCD_BAR_WORDS 3456
#define XB_SPIN_CAP (1u << 18)
__device__ __forceinline__ unsigned xb_ld(unsigned* p)              { return __hip_atomic_load(p, __ATOMIC_RELAXED, __HIP_MEMORY_SCOPE_AGENT); }
__device__ __forceinline__ unsigned xb_add(unsigned* p, unsigned v) { return __hip_atomic_fetch_add(p, v, __ATOMIC_RELAXED, __HIP_MEMORY_SCOPE_AGENT); }
__device__ __forceinline__ unsigned xb_xcc_id() { return (unsigned)__builtin_amdgcn_s_getreg((3 << 11) | 20) & 0xFu; }
#define XB_SPIN(cond, bar) do { unsigned _sp = 0; while (cond) { __builtin_amdgcn_s_sleep(1); \
    if ((++_sp & 255u) == 0u) { if (xb_ld(&(bar)[XB_TMO])) break; if (_sp > XB_SPIN_CAP) { atomicAdd(&(bar)[XB_TMO], 1u); break; } } } } while (0)
struct XcdBarrier { unsigned* bar; unsigned x; volatile LAS unsigned* st; };
__device__ __forceinline__ XcdBarrier xcd_barrier_post(unsigned* bar, volatile LAS unsigned* st) {
    XcdBarrier b; b.bar = bar; b.x = xb_xcc_id(); b.st = st;
    if (threadIdx.x == 0) (void)xb_add(&bar[XB_XCNT(b.x)], 1u);
    return b;
}
__device__ __forceinline__ void xcd_barrier_complete(unsigned* bar, unsigned x, unsigned& nloc, unsigned& nx) {
    const unsigned G = gridDim.x * gridDim.y * gridDim.z;
    unsigned sum, cnt, mine, sp = 0u;
    for (;;) {
        sum = 0u; cnt = 0u; mine = 0u;
#pragma unroll
        for (unsigned j = 0; j < 16; ++j) { const unsigned c = xb_ld(&bar[XB_XCNT(j)]); sum += c; cnt += (c > 0u) ? 1u : 0u; mine = (j == x) ? c : mine; }
        if (sum == G) break;
        __builtin_amdgcn_s_sleep(1);
        if ((++sp & 255u) == 0u) { if (xb_ld(&bar[XB_TMO])) break; if (sp > XB_SPIN_CAP) { atomicAdd(&bar[XB_TMO], 1u); break; } }
    }
    nloc = mine > 0u ? mine : 1u; nx = cnt > 0u ? cnt : 1u;
}
__device__ __forceinline__ void xcd_barrier(const XcdBarrier& b) {
    asm volatile("s_waitcnt vmcnt(0)" ::: "memory");
    __syncthreads();
    if (threadIdx.x == 0) {
        unsigned* bar = b.bar;
        __builtin_amdgcn_s_waitcnt(0);
        unsigned nloc = b.st[0], nx = b.st[1];
        if (nloc == 0u) { xcd_barrier_complete(bar, b.x, nloc, nx); b.st[0] = nloc; b.st[1] = nx; }
        const unsigned old = xb_add(&bar[XB_XSUB(b.x)], 1u);
        const unsigned gen = old / nloc;
        if (old + 1u == (gen + 1u) * nloc) {
            __builtin_amdgcn_fence(__ATOMIC_RELEASE, "agent");
            asm volatile("s_waitcnt vmcnt(0)" ::: "memory");
            const unsigned og = xb_add(&bar[XB_TOP], 1u);
            const unsigned tg = og / nx;
            if (og + 1u == (tg + 1u) * nx) xb_add(&bar[XB_TOPGEN], 1u);
            else XB_SPIN(xb_ld(&bar[XB_TOPGEN]) == tg, bar);
            __builtin_amdgcn_fence(__ATOMIC_ACQUIRE, "agent");
            xb_add(&bar[XB_XGEN(b.x)], 1u);
            asm volatile("s_waitcnt vmcnt(0)" ::: "memory");
        } else {
            XB_SPIN(xb_ld(&bar[XB_XGEN(b.x)]) == gen, bar);
            __builtin_amdgcn_fence(__ATOMIC_ACQUIRE, "agent");
            asm volatile("s_waitcnt vmcnt(0)" ::: "memory");
        }
    }
    __syncthreads();
}

struct Args { const float* in[12]; float* out; unsigned char* ws; };

__global__ void __launch_bounds__(512, 2) fwd_megakernel(Args a) {
    extern __shared__ __attribute__((aligned(16))) unsigned char lds_raw[];
    LAS unsigned char* lds = (LAS unsigned char*)lds_raw;
    cg::grid_group grid = cg::this_grid();
    const int tid = threadIdx.x, lane = tid & 63, wave = __builtin_amdgcn_readfirstlane(tid >> 6);
    const int G = gridDim.x, bx = blockIdx.x;
    const float* x_prompt = a.in[0]; const float* x_sample = a.in[1]; const float* rel_bias = a.in[2];
    const float* w_in_ab = a.in[3]; const float* pool_w = a.in[4]; const float* pool_scale = a.in[5]; const float* w_out_ab = a.in[6];
    const float* w_in_c = a.in[7]; const float* conv_w = a.in[8]; const float* w_out_c = a.in[9]; const float* ln_g = a.in[10]; const float* ln_b = a.in[11];
    unsigned char* dout = (unsigned char*)a.out;
    bf16_t* XB = (bf16_t*)(dout + DO_XB); bf16_t* OACC = XB;
    bf16_t* WT1 = (bf16_t*)(dout + DO_WT1); bf16_t* WT2 = (bf16_t*)(dout + DO_WT2); bf16_t* WT3 = (bf16_t*)(dout + DO_WT3);
    bf16_t* WT4 = (bf16_t*)(dout + DO_WT4); bf16_t* WT5 = (bf16_t*)(dout + DO_WT5);
    bf16_t* RA = (bf16_t*)(a.ws + WS_H0); bf16_t* RB = (bf16_t*)(a.ws + WS_RB); float* LACC = (float*)(a.ws + WS_LACC); float* STAT = (float*)(a.ws + WS_STAT);
    const int gw = bx * 8 + wave, NGW = G * 8;
    const int gt = bx * 512 + tid, NGT = G * 512;
    constexpr int BIG = 1 << 30;
    unsigned* barw = (unsigned*)(a.ws + WS_BAR);
    volatile LAS unsigned* lds_st = (volatile LAS unsigned*)(lds + LDS_BYTES - 64);
    if (bx == 0) { for (int i = tid; i < XCD_BAR_WORDS; i += 512) barw[i] = 0u; }
    if (tid < 2) lds_st[tid] = 0u;
    __syncthreads();

    for (int rep = 0; rep < (EXP == 3 ? 2 : 1); ++rep) {
        LAS float* scr = (LAS float*)(lds + wave * 16384);
        constexpr int I1 = 32 * 320, I2 = 48 * 64, I3 = 32 * 256, I4 = 32 * 64, I5 = 4 * 4 * 8;
        for (int it = gw; it < I1 + I2 + I3 + I4 + I5; it += NGW) {
            int r = it;
            if (r < I1) { const int kb = r / 320, nb = r % 320; transpose_item(w_in_ab, 10240, 64 * kb, 32 * nb, WT1, 2048, 32 * nb, scr, lane); continue; } r -= I1;
            if (r < I2) { const int kb = r / 64, nb = r % 64; transpose_item(w_out_ab, 2048, 64 * kb, 32 * nb, WT2, 3072, 32 * nb, scr, lane); continue; } r -= I2;
            if (r < I3) { const int kb = r / 256, nb = r % 256; const int n0 = 32 * nb, part = n0 >> 11, chn = n0 & 2047;
                const int type = (part == 0 || part == 3) ? 1 : 0, bj = (part >= 2) ? 1 : 0;
                const int drow = 256 * (2 * (chn >> 7) + type) + 128 * bj + (chn & 127);
                transpose_item(w_in_c, 8192, 64 * kb, n0, WT3, 2048, drow, scr, lane); continue; } r -= I3;
            if (r < I4) { const int kb = r / 64, nb = r % 64; transpose_item(w_out_c, 2048, 64 * kb, 32 * nb, WT4, 2048, 32 * nb, scr, lane); continue; } r -= I4;
            { const int gi = r >> 5, rr = r & 31, kb = rr >> 3, nb = rr & 7; transpose_item(pool_w + (size_t)gi * 65536, 256, 64 * kb, 32 * nb, WT5, 256, gi * 256 + 32 * nb, scr, lane); }
        }
        for (size_t i = gt; i < (size_t)MT * DM / 8; i += (size_t)NGT * 4) {
            f32x4 v0[4], v1[4];
#pragma unroll
            for (int u = 0; u < 4; ++u) { const size_t ii = i + (size_t)u * NGT; if (ii < (size_t)MT * DM / 8) { const size_t e = ii * 8; const float* src = e < (size_t)MP * DM ? x_prompt + e : x_sample + (e - (size_t)MP * DM);
                v0[u] = *(const f32x4*)src; v1[u] = *(const f32x4*)(src + 4); } }
#pragma unroll
            for (int u = 0; u < 4; ++u) { const size_t ii = i + (size_t)u * NGT; if (ii < (size_t)MT * DM / 8) { const size_t e = ii * 8;
                u32x4 o; o.x = pk2(v0[u][0], v0[u][1]); o.y = pk2(v0[u][2], v0[u][3]); o.z = pk2(v1[u][0], v1[u][1]); o.w = pk2(v1[u][2], v1[u][3]);
                *(u32x4*)(XB + e) = o; } } }
    }
    grid.sync();
    XcdBarrier xbar = xcd_barrier_post(barw, lds_st);
#define GRID_SYNC() xcd_barrier(xbar)
    if (EXP == 4) { for (int r = 0; r < 10; ++r) GRID_SYNC(); }
    {
        { pg8::Gemm g{XB, WT1, MT, 6144, 2048, 2048, 2048, 0, BIG, 0}; pg8::StaticOrder S; S.init(MT, 6144, G, bx);
          pg8::EpiHead E{RA, QSCALE};
          pg8::gemm_phase<pg8::EpiHead>(lds, g, S, E); }
        __syncthreads();
        { pg8::Gemm g{XB, WT1 + (size_t)6144 * 2048, MT, 4096, 2048, 2048, 2048, 0, BIG, 0}; pg8::StaticOrder S; S.init(MT, 4096, G, bx);
          pg8::EpiBf16 E{RB, LDB, 0, 1.f};
          pg8::gemm_phase<pg8::EpiBf16>(lds, g, S, E); }
    }
    GRID_SYNC();
    {
        pg8::Gemm g{RB + B_UB, WT5, MT, 1024, 256, LDB, 256, 256, BIG, 0}; pg8::StaticOrder S; S.init(MT, 1024, G, bx);
        pg8::EpiBf16 E{RB + B_UB, LDB, 0, 1.f};
        pg8::gemm_phase<pg8::EpiBf16>(lds, g, S, E);
        __syncthreads();
        for (int sb = bx; sb < 768; sb += G) {
            const int c5 = sb >> 4, sbh = sb & 15; int sseq, sS, sblk;
            if (c5 < 16) { sseq = (c5 >> 2) * 2048; sS = 2048; sblk = c5 & 3; } else { sseq = MP; sS = 16384; sblk = c5 - 16; }
            attn_pass<0, true>(lds, RA, RB, OACC, LACC, rel_bias, sseq, sS, sblk, sbh);
            asm volatile("s_waitcnt vmcnt(0)" ::: "memory"); __syncthreads();
            attn_pass<1, true>(lds, RA, RB, OACC, LACC, rel_bias, sseq, sS, sblk, sbh);
        }
    }
    GRID_SYNC();
    {
#define POOL_GROUP(GI) \
        for (int idx = gt; idx < MT * 32; idx += NGT) { \
            constexpr int HW = 1 << (GI), WIN = 2 * HW; \
            const int row = idx >> 5, c0 = (GI) * 256 + (idx & 31) * 8; \
            int t, S; if (row < MP) { t = row & 2047; S = 2048; } else { t = row - MP; S = 16384; } \
            const bf16_t* base = RB + (size_t)(row - t) * LDB + B_UB + c0; \
            u32x4 v[WIN]; \
            _Pragma("unroll") for (int k = 0; k < WIN; ++k) { int tt = t - HW + k; tt = tt < 0 ? 0 : (tt > S - 1 ? S - 1 : tt); v[k] = *(const u32x4*)(base + (size_t)tt * LDB); } \
            bf16_t* gp = RB + (size_t)row * LDB + B_GB + c0; \
            const u32x4 gv = *(const u32x4*)gp; \
            const f32x4 sc0 = *(const f32x4*)(pool_scale + c0), sc1 = *(const f32x4*)(pool_scale + c0 + 4); \
            float acc8[8]; \
            _Pragma("unroll") for (int j = 0; j < 8; ++j) acc8[j] = 0.f; \
            _Pragma("unroll") for (int k = 0; k < WIN; ++k) { const int tt = t - HW + k; const float m = (tt >= 0 && tt < S) ? 1.f : 0.f; \
                acc8[0] += m * bf_lo(v[k].x); acc8[1] += m * bf_hi(v[k].x); acc8[2] += m * bf_lo(v[k].y); acc8[3] += m * bf_hi(v[k].y); \
                acc8[4] += m * bf_lo(v[k].z); acc8[5] += m * bf_hi(v[k].z); acc8[6] += m * bf_lo(v[k].w); acc8[7] += m * bf_hi(v[k].w); } \
            const int lo = (t - HW) < 0 ? 0 : t - HW, hi = (t + HW - 1) > S - 1 ? S - 1 : t + HW - 1; \
            const float rc = 1.0f / (float)(hi - lo + 1); \
            const u32x4 sv = v[HW]; \
            float r8[8]; \
            r8[0] = (acc8[0] * rc - bf_lo(sv.x)) * sc0[0] * pg8::silu_f(bf_lo(gv.x)); r8[1] = (acc8[1] * rc - bf_hi(sv.x)) * sc0[1] * pg8::silu_f(bf_hi(gv.x)); \
            r8[2] = (acc8[2] * rc - bf_lo(sv.y)) * sc0[2] * pg8::silu_f(bf_lo(gv.y)); r8[3] = (acc8[3] * rc - bf_hi(sv.y)) * sc0[3] * pg8::silu_f(bf_hi(gv.y)); \
            r8[4] = (acc8[4] * rc - bf_lo(sv.z)) * sc1[0] * pg8::silu_f(bf_lo(gv.z)); r8[5] = (acc8[5] * rc - bf_hi(sv.z)) * sc1[1] * pg8::silu_f(bf_hi(gv.z)); \
            r8[6] = (acc8[6] * rc - bf_lo(sv.w)) * sc1[2] * pg8::silu_f(bf_lo(gv.w)); r8[7] = (acc8[7] * rc - bf_hi(sv.w)) * sc1[3] * pg8::silu_f(bf_hi(gv.w)); \
            u32x4 o; o.x = pk2(r8[0], r8[1]); o.y = pk2(r8[2], r8[3]); o.z = pk2(r8[4], r8[5]); o.w = pk2(r8[6], r8[7]); \
            *(u32x4*)gp = o; }
        POOL_GROUP(0) POOL_GROUP(1) POOL_GROUP(2) POOL_GROUP(3)
#undef POOL_GROUP
    }
    attn_pass<2>(lds, RA, RB, OACC, LACC, rel_bias);
    GRID_SYNC();
    {
        pg8::Gemm g{RB, WT2, MT, 2048, 3072, LDB, 3072, 0, 32, (B_GB - 2048) * 2}; pg8::StaticOrder S; S.init(MT, 2048, G, bx);
        pg8::EpiResBf E{x_prompt, x_sample, MP, DM, RA + A_Y0, LDA, DN_ALPHA};
        pg8::gemm_phase<pg8::EpiResBf>(lds, g, S, E);
    }
    GRID_SYNC();
#define LN_PHASE(LAYER, SRC_COL, WRITE_BF, WRITE_F32) { \
    int ln_lane = (int)__builtin_amdgcn_mbcnt_hi(~0u, __builtin_amdgcn_mbcnt_lo(~0u, 0u)); asm volatile("" : "+v"(ln_lane));        \
    f32x4 gg[8], bb[8]; \
    _Pragma("unroll") for (int j = 0; j < 4; ++j) { const float* gp_ = ln_g + (LAYER) * DM + 8 * (ln_lane + 64 * j); const float* bp_ = ln_b + (LAYER) * DM + 8 * (ln_lane + 64 * j); \
        gg[2 * j] = *(const f32x4*)gp_; gg[2 * j + 1] = *(const f32x4*)(gp_ + 4); bb[2 * j] = *(const f32x4*)bp_; bb[2 * j + 1] = *(const f32x4*)(bp_ + 4); } \
    u32x4 rv[4], rn[4]; int row = gw; \
    if (row < MT) { const u32x4* src = (const u32x4*)(RA + (size_t)row * LDA + (SRC_COL)) + ln_lane; _Pragma("unroll") for (int j = 0; j < 4; ++j) rv[j] = src[64 * j]; } \
    while (row < MT) { \
        const int nrow = row + NGW; \
        if (nrow < MT) { const u32x4* srcn = (const u32x4*)(RA + (size_t)nrow * LDA + (SRC_COL)) + ln_lane; _Pragma("unroll") for (int j = 0; j < 4; ++j) rn[j] = srcn[64 * j]; } \
        f32x4 v[8]; float s = 0.f; \
        _Pragma("unroll") for (int j = 0; j < 4; ++j) { v[2 * j] = (f32x4){hlo(rv[j].x), hhi(rv[j].x), hlo(rv[j].y), hhi(rv[j].y)}; v[2 * j + 1] = (f32x4){hlo(rv[j].z), hhi(rv[j].z), hlo(rv[j].w), hhi(rv[j].w)}; } \
        _Pragma("unroll") for (int j = 0; j < 8; ++j) { s += (v[j][0] + v[j][1]) + (v[j][2] + v[j][3]); } \
        const float mean = wave_sum(s) * (1.0f / DM); float s2 = 0.f; \
        _Pragma("unroll") for (int j = 0; j < 8; ++j) { v[j] = v[j] - mean; s2 += (v[j][0] * v[j][0] + v[j][1] * v[j][1]) + (v[j][2] * v[j][2] + v[j][3] * v[j][3]); } \
        const float rstd = 1.0f / sqrtf(wave_sum(s2) * (1.0f / DM) + LN_EPS); \
        if ((WRITE_BF) && ln_lane == 0) { *(f32x2*)(STAT + (size_t)row * 2) = (f32x2){mean, rstd}; } \
        _Pragma("unroll") for (int j = 0; j < 4; ++j) { \
            const f32x4 y0 = v[2 * j] * rstd * gg[2 * j] + bb[2 * j], y1 = v[2 * j + 1] * rstd * gg[2 * j + 1] + bb[2 * j + 1]; \
            if (WRITE_F32) { float* dp_ = a.out + (size_t)row * DM + 8 * (ln_lane + 64 * j); __builtin_nontemporal_store(y0, (f32x4*)dp_); __builtin_nontemporal_store(y1, (f32x4*)(dp_ + 4)); }        \
            if (WRITE_BF) { u32x4 o; o.x = pk2(y0[0], y0[1]); o.y = pk2(y0[2], y0[3]); o.z = pk2(y1[0], y1[1]); o.w = pk2(y1[2], y1[3]); *((u32x4*)(RA + (size_t)row * LDA + A_X1) + ln_lane + 64 * j) = o; } } \
        _Pragma("unroll") for (int j = 0; j < 4; ++j) rv[j] = rn[j]; \
        row = nrow; } }
    LN_PHASE(0, A_Y0, true, false)
    GRID_SYNC();
    {
        pg8::Gemm g{RA + A_X1, WT3, MT, 8192, 2048, LDA, 2048, 0, BIG, 0}; pg8::StaticOrder S; S.init(MT, 8192, G, bx);
        pg8::EpiPair E{RB, RB + 2048, LDB};
        pg8::gemm_phase<pg8::EpiPair>(lds, g, S, E);
    }
    GRID_SYNC();
    for (int rep = 0; rep < (EXP == 5 ? 2 : 1); ++rep)
    for (int idx0 = gt; idx0 < MT * 256; idx0 += 2 * NGT) {
        u32x4 z0[2], z1[2], z2[2], wg[2]; f32x4 cw[2][3][2];
#pragma unroll
        for (int u = 0; u < 2; ++u) { const int idx = idx0 + u * NGT; if (idx < MT * 256) {
            const int row = idx >> 8, c0 = (idx & 255) * 8;
            int t, S; if (row < MP) { t = row & 2047; S = 2048; } else { t = row - MP; S = 16384; }
            const bf16_t* zp = RB + (size_t)row * LDB + c0;
            z1[u] = *(const u32x4*)zp; z0[u] = (u32x4){0u, 0u, 0u, 0u}; z2[u] = (u32x4){0u, 0u, 0u, 0u};
            if (t > 0) z0[u] = *(const u32x4*)(zp - LDB);
            if (t < S - 1) z2[u] = *(const u32x4*)(zp + LDB);
            wg[u] = *(const u32x4*)(zp + 2048);
#pragma unroll
            for (int k = 0; k < 3; ++k) { cw[u][k][0] = *(const f32x4*)(conv_w + k * 2048 + c0); cw[u][k][1] = *(const f32x4*)(conv_w + k * 2048 + c0 + 4); } } }
#pragma unroll
        for (int u = 0; u < 2; ++u) { const int idx = idx0 + u * NGT; if (idx < MT * 256) {
            const int row = idx >> 8, c0 = (idx & 255) * 8;
            float r8[8];
#define CONV1(J, Z0, Z1, Z2, WG) r8[J] = (WG) * (cw[u][0][(J) >> 2][(J) & 3] * (Z0) + cw[u][1][(J) >> 2][(J) & 3] * (Z1) + cw[u][2][(J) >> 2][(J) & 3] * (Z2));
            CONV1(0, bf_lo(z0[u].x), bf_lo(z1[u].x), bf_lo(z2[u].x), bf_lo(wg[u].x)) CONV1(1, bf_hi(z0[u].x), bf_hi(z1[u].x), bf_hi(z2[u].x), bf_hi(wg[u].x))
            CONV1(2, bf_lo(z0[u].y), bf_lo(z1[u].y), bf_lo(z2[u].y), bf_lo(wg[u].y)) CONV1(3, bf_hi(z0[u].y), bf_hi(z1[u].y), bf_hi(z2[u].y), bf_hi(wg[u].y))
            CONV1(4, bf_lo(z0[u].z), bf_lo(z1[u].z), bf_lo(z2[u].z), bf_lo(wg[u].z)) CONV1(5, bf_hi(z0[u].z), bf_hi(z1[u].z), bf_hi(z2[u].z), bf_hi(wg[u].z))
            CONV1(6, bf_lo(z0[u].w), bf_lo(z1[u].w), bf_lo(z2[u].w), bf_lo(wg[u].w)) CONV1(7, bf_hi(z0[u].w), bf_hi(z1[u].w), bf_hi(z2[u].w), bf_hi(wg[u].w))
#undef CONV1
            u32x4 o; o.x = pk2(r8[0], r8[1]); o.y = pk2(r8[2], r8[3]); o.z = pk2(r8[4], r8[5]); o.w = pk2(r8[6], r8[7]);
            *(u32x4*)(RA + (size_t)row * LDA + A_X1 + c0) = o; } } }
    GRID_SYNC();
    {
        pg8::Gemm g{RA + A_X1, WT4, MT, 2048, 2048, LDA, 2048, 0, BIG, 0}; pg8::StaticOrder S; S.init(MT, 2048, G, bx);
        pg8::EpiResLnBf E{RA + A_Y0, LDA, STAT, ln_g, ln_b, RA + A_Y1, LDA, DN_ALPHA};
        pg8::gemm_phase<pg8::EpiResLnBf>(lds, g, S, E);
    }
    GRID_SYNC();
    LN_PHASE(1, A_Y1, false, true)
#undef LN_PHASE
}

extern "C" void kernel_launch(void* const* d_in, const int* in_sizes, int n_in, void* d_out, int out_size, void* d_ws, size_t ws_size, hipStream_t stream) {
    static int grid = 0;
    if (grid == 0) {
        if (n_in != 12 || out_size != MT * DM || ws_size < WS_END) { fprintf(stderr, "kernel_launch: unexpected shapes (n_in %d out %d ws %zu need %zu)\n", n_in, out_size, ws_size, (size_t)WS_END); grid = -1; return; }
        int dev = 0, cus = 0, per_cu = 0;
        (void)hipGetDevice(&dev); (void)hipDeviceGetAttribute(&cus, hipDeviceAttributeMultiprocessorCount, dev);
        (void)hipFuncSetAttribute((const void*)fwd_megakernel, hipFuncAttributeMaxDynamicSharedMemorySize, LDS_BYTES);
        (void)hipOccupancyMaxActiveBlocksPerMultiprocessor(&per_cu, (const void*)fwd_megakernel, 512, LDS_BYTES);
        (void)hipGetLastError();
        if (per_cu < 1) per_cu = 1;
        if (cus < 1) cus = 256;
        grid = cus;
    }
    if (grid < 0) return;
    Args a{};
    for (int i = 0; i < 12; ++i) a.in[i] = (const float*)d_in[i];
    a.out = (float*)d_out; a.ws = (unsigned char*)d_ws;
    void* args[] = {&a};
    hipError_t e = hipLaunchCooperativeKernel((const void*)fwd_megakernel, dim3(grid), dim3(512), args, LDS_BYTES, stream);
    if (e != hipSuccess) fprintf(stderr, "cooperative launch failed: %s (grid %d)\n", hipGetErrorString(e), grid);
}
```

```cpp
#include <hip/hip_runtime.h>
#include <hip/hip_cooperative_groups.h>
#include <cstdio>
#include <cstdint>
namespace cg = cooperative_groups;
#ifndef EXP
#define EXP 0
#endif

#define LAS __attribute__((address_space(3)))
typedef unsigned short bf16_t;
typedef short bf16x8 __attribute__((ext_vector_type(8)));
typedef short s16x4 __attribute__((ext_vector_type(4)));
typedef float f32x4 __attribute__((ext_vector_type(4)));
typedef float f32x2 __attribute__((ext_vector_type(2)));
typedef unsigned u32x4 __attribute__((ext_vector_type(4)));
typedef unsigned u32x2 __attribute__((ext_vector_type(2)));

constexpr int DM = 2048, MP = 8192, MS = 16384, MT = MP + MS;
constexpr int LDH = 10240;
constexpr int C_Q = 0, C_K = 2048, C_V = 4096, C_GA = 6144, C_UB = 8192, C_GB = 9216;
constexpr int LDA = 6144, LDB = 4096; constexpr size_t HEADSZ = (size_t)MT * 128, PARTSZ = (size_t)MT * 2048, WS_RB = (size_t)MT * 6144 * 2;
constexpr int A_Y0 = 0, A_Y1 = 2048, A_X1 = 4096, B_GA = 0, B_UB = 2048, B_GB = 3072;
constexpr float LOG2E = 1.4426950408889634f;
constexpr float QSCALE = 0.08838834764831845f * LOG2E;
constexpr float DN_ALPHA = 1.4142135623730951f;
constexpr float LN_EPS = 1e-5f;
constexpr int LDS_BYTES = 147456;

constexpr size_t DO_XB = 0;
constexpr size_t DO_WT1 = 100663296;
constexpr size_t DO_WT2 = DO_WT1 + 41943040;
constexpr size_t DO_WT3 = DO_WT2 + 12582912;
constexpr size_t DO_WT4 = DO_WT3 + 33554432;
constexpr size_t DO_WT5 = DO_WT4 + 8388608;
static_assert(DO_WT5 + 524288 <= (size_t)MT * DM * 4, "d_out scratch map");
constexpr size_t WS_H0 = 0, WS_BAR = (size_t)MT * LDH * 2, WS_LACC = (size_t)MT * LDH * 2 + 1048576, WS_STAT = WS_LACC + (size_t)MT * 16 * 4, WS_END = WS_STAT + (size_t)MT * 2 * 4;

typedef _Float16 h16x2 __attribute__((ext_vector_type(2)));
__device__ __forceinline__ unsigned pkh(float lo, float hi) { h16x2 v; v.x = (_Float16)lo; v.y = (_Float16)hi; return __builtin_bit_cast(unsigned, v); }
__device__ __forceinline__ float hlo(unsigned w) { return (float)__builtin_bit_cast(h16x2, w).x; }
__device__ __forceinline__ float hhi(unsigned w) { return (float)__builtin_bit_cast(h16x2, w).y; }

namespace pg8 {
constexpr int BM = 256, BK = 64, HALF = 128, HTB = HALF * BK * 2, STAGE_BYTES = 8 * HTB, NXCD = 8, WGM = 8;
__host__ __device__ __forceinline__ int lds_byte(int r, int c) { const int st = (r >> 4) * 2 + (c >> 5), rr = r & 15, cc = c & 31, ob = rr * 64 + cc * 2; return st * 1024 + (ob ^ (((ob >> 9) & 1) << 5)); }
__host__ __device__ __forceinline__ void stage_rc(int b, int& R, int& C) { const int st = b / 1024, sb = b % 1024, swz = sb ^ (((sb >> 9) & 1) << 5); R = (st >> 1) * 16 + swz / 64; C = (st & 1) * 32 + (swz % 64) / 2; }
__host__ __device__ __forceinline__ int perm32(int rho) { const int n = rho >> 4, i = rho & 15; return 8 * (i >> 2) + 4 * n + (i & 3); }

struct Unit { int pm, pn; };
struct Gemm { const bf16_t* A; const bf16_t* Bt; int M, N, K, lda, ldb, a_pn_off, tsplit, ajump; };

struct StaticOrder {
    int nM, nN, nwg, G, c;
    __host__ __device__ void init(int M, int N, int G_, int c_) { nM = M / BM; nN = N / BM; nwg = nM * nN; G = G_; c = c_; }
    __host__ __device__ bool next(int i, Unit& u) const {
        const long L = (long)i * G + c; if (L >= nwg) return false;
        int wgid = (int)L; { const int q = nwg / NXCD, r = nwg % NXCD, xcd = wgid % NXCD, off = wgid / NXCD; wgid = (xcd < r ? xcd * (q + 1) : r * (q + 1) + (xcd - r) * q) + off; }
        const int nig = WGM * nN, gid = wgid / nig, fm = gid * WGM, gsz = (nM - fm) < WGM ? (nM - fm) : WGM;
        u.pm = fm + ((wgid % nig) % gsz); u.pn = (wgid % nig) / gsz; return true;
    }
};

__device__ __forceinline__ unsigned cvt_pk_bf16(float lo, float hi) { unsigned r; asm volatile("v_cvt_pk_bf16_f32 %0, %1, %2" : "=v"(r) : "v"(lo), "v"(hi)); return r; }
__device__ __forceinline__ float silu_f(float x) { return x * __builtin_amdgcn_rcpf(1.0f + __builtin_amdgcn_exp2f(-x * LOG2E)); }

struct EpiBf16 {
    static constexpr bool PERM = true;
    bf16_t* O; int ldc; int split_cols; float scale0;
    __device__ __forceinline__ void operator()(const f32x4 (&acc)[2][2][4][2], const Unit& u, int wr, int wc, int fr, int fq) const {
        const int row0 = u.pm * BM + wr * 64 + fr; const int colt = u.pn * BM;
        float sc = 1.f; if (split_cols) { if (colt < split_cols) sc = scale0; }
        const int col0 = colt + wc * 32 + 8 * fq;
#pragma unroll
        for (int ai = 0; ai < 2; ++ai)
#pragma unroll
            for (int m = 0; m < 4; ++m) { bf16_t* rowp = O + (size_t)(row0 + ai * HALF + m * 16) * ldc + col0;
#pragma unroll
                for (int bj = 0; bj < 2; ++bj) { f32x4 v0 = acc[ai][bj][m][0] * sc, v1 = acc[ai][bj][m][1] * sc;
                    u32x4 w; w.x = cvt_pk_bf16(v0[0], v0[1]); w.y = cvt_pk_bf16(v0[2], v0[3]); w.z = cvt_pk_bf16(v1[0], v1[1]); w.w = cvt_pk_bf16(v1[2], v1[3]);
                    *(u32x4*)(rowp + bj * HALF) = w; } }
    }
};
struct EpiHead {
    static constexpr bool PERM = true;
    bf16_t* RA; float scale0;
    __device__ __forceinline__ void operator()(const f32x4 (&acc)[2][2][4][2], const Unit& u, int wr, int wc, int fr, int fq) const {
        const int row0 = u.pm * BM + wr * 64 + fr; const int colt = u.pn * BM;
        const float sc = colt < 2048 ? scale0 : 1.f;
        bf16_t* base = RA + (size_t)(colt >> 7) * HEADSZ + (size_t)row0 * 128 + wc * 32 + 8 * fq;
#pragma unroll
        for (int ai = 0; ai < 2; ++ai)
#pragma unroll
            for (int m = 0; m < 4; ++m) { bf16_t* rowp = base + (ai * HALF + m * 16) * 128;
#pragma unroll
                for (int bj = 0; bj < 2; ++bj) { f32x4 v0 = acc[ai][bj][m][0] * sc, v1 = acc[ai][bj][m][1] * sc;
                    u32x4 w; w.x = cvt_pk_bf16(v0[0], v0[1]); w.y = cvt_pk_bf16(v0[2], v0[3]); w.z = cvt_pk_bf16(v1[0], v1[1]); w.w = cvt_pk_bf16(v1[2], v1[3]);
                    *(u32x4*)(rowp + bj * HEADSZ) = w; } }
    }
};
__device__ __forceinline__ float bfl(unsigned w) { return __builtin_bit_cast(float, w << 16); }
__device__ __forceinline__ float bfh(unsigned w) { return __builtin_bit_cast(float, w & 0xffff0000u); }
struct EpiResBf {
    static constexpr bool PERM = true;
    const float* res0; const float* res1; int split_row; int ldr; bf16_t* out; int ldo; float alpha;
    __device__ __forceinline__ void operator()(const f32x4 (&acc)[2][2][4][2], const Unit& u, int wr, int wc, int fr, int fq) const {
        const int col0 = u.pn * BM + wc * 32 + 8 * fq;
#pragma unroll
        for (int am = 0; am < 4; ++am) { const int ai = am >> 1, m0 = (am & 1) * 2;
            f32x4 r[2][2][2];
#pragma unroll
            for (int mm = 0; mm < 2; ++mm) { const int m = m0 + mm; const int row = u.pm * BM + ai * HALF + wr * 64 + m * 16 + fr;
                const float* rp = (row < split_row ? res0 + (size_t)row * ldr : res1 + (size_t)(row - split_row) * ldr) + col0;
#pragma unroll
                for (int bj = 0; bj < 2; ++bj) { r[mm][bj][0] = *(const f32x4*)(rp + bj * HALF); r[mm][bj][1] = *(const f32x4*)(rp + bj * HALF + 4); } }
            asm volatile("" ::: "memory"); __builtin_amdgcn_sched_barrier(0);
#pragma unroll
            for (int mm = 0; mm < 2; ++mm) { const int m = m0 + mm; const int row = u.pm * BM + ai * HALF + wr * 64 + m * 16 + fr;
                bf16_t* op = out + (size_t)row * ldo + col0;
#pragma unroll
                for (int bj = 0; bj < 2; ++bj) { const f32x4 y0 = r[mm][bj][0] * alpha + acc[ai][bj][m][0], y1 = r[mm][bj][1] * alpha + acc[ai][bj][m][1];
                    u32x4 w; w.x = pkh(y0[0], y0[1]); w.y = pkh(y0[2], y0[3]); w.z = pkh(y1[0], y1[1]); w.w = pkh(y1[2], y1[3]);
                    *(u32x4*)(op + bj * HALF) = w; } }
            asm volatile("" ::: "memory"); __builtin_amdgcn_sched_barrier(0);
        }
    }
};
struct EpiResLnBf {
    static constexpr bool PERM = true;
    const bf16_t* y; int ldy; const float* stats; const float* gam; const float* bet; bf16_t* out; int ldo; float alpha;
    __device__ __forceinline__ void operator()(const f32x4 (&acc)[2][2][4][2], const Unit& u, int wr, int wc, int fr, int fq) const {
        const int col0 = u.pn * BM + wc * 32 + 8 * fq;
        f32x4 gg[2][2], bb[2][2];
#pragma unroll
        for (int bj = 0; bj < 2; ++bj)
#pragma unroll
            for (int n = 0; n < 2; ++n) { gg[bj][n] = *(const f32x4*)(gam + col0 + bj * HALF + n * 4) * alpha; bb[bj][n] = *(const f32x4*)(bet + col0 + bj * HALF + n * 4) * alpha; }
#pragma unroll
        for (int ai = 0; ai < 2; ++ai) {
            u32x4 yv[4][2]; f32x2 st[4];
#pragma unroll
            for (int m = 0; m < 4; ++m) { const int row = u.pm * BM + ai * HALF + wr * 64 + m * 16 + fr;
                st[m] = *(const f32x2*)(stats + (size_t)row * 2);
                const bf16_t* yp = y + (size_t)row * ldy + col0;
#pragma unroll
                for (int bj = 0; bj < 2; ++bj) yv[m][bj] = *(const u32x4*)(yp + bj * HALF); }
            asm volatile("" ::: "memory"); __builtin_amdgcn_sched_barrier(0);
#pragma unroll
            for (int m = 0; m < 4; ++m) { const int row = u.pm * BM + ai * HALF + wr * 64 + m * 16 + fr;
                bf16_t* op = out + (size_t)row * ldo + col0;
#pragma unroll
                for (int bj = 0; bj < 2; ++bj) { const u32x4 v = yv[m][bj];
                    const f32x4 r0 = (f32x4){hlo(v.x), hhi(v.x), hlo(v.y), hhi(v.y)}, r1 = (f32x4){hlo(v.z), hhi(v.z), hlo(v.w), hhi(v.w)};
                    const f32x4 y0 = (r0 - st[m].x) * st[m].y * gg[bj][0] + bb[bj][0] + acc[ai][bj][m][0], y1 = (r1 - st[m].x) * st[m].y * gg[bj][1] + bb[bj][1] + acc[ai][bj][m][1];
                    u32x4 w; w.x = pkh(y0[0], y0[1]); w.y = pkh(y0[2], y0[3]); w.z = pkh(y1[0], y1[1]); w.w = pkh(y1[2], y1[3]);
                    *(u32x4*)(op + bj * HALF) = w; } }
            asm volatile("" ::: "memory"); __builtin_amdgcn_sched_barrier(0);
        }
    }
};
struct EpiRes {
    static constexpr bool PERM = false;
    const float* res0; const float* res1; int split_row; int ldr; float* out; int ldo; float alpha;
    __device__ __forceinline__ void operator()(const f32x4 (&acc)[2][2][4][2], const Unit& u, int wr, int wc, int fr, int fq) const {
        const int col0 = u.pn * BM + wc * 32 + 4 * fq;
#pragma unroll
        for (int ai = 0; ai < 2; ++ai)
#pragma unroll
            for (int m = 0; m < 4; ++m) { const int row = u.pm * BM + ai * HALF + wr * 64 + m * 16 + fr;
                const float* rp = (row < split_row ? res0 + (size_t)row * ldr : res1 + (size_t)(row - split_row) * ldr) + col0;
                float* op = out + (size_t)row * ldo + col0;
#pragma unroll
                for (int bj = 0; bj < 2; ++bj)
#pragma unroll
                    for (int n = 0; n < 2; ++n) { const f32x4 r = *(const f32x4*)(rp + bj * HALF + n * 16); *(f32x4*)(op + bj * HALF + n * 16) = r * alpha + acc[ai][bj][m][n]; } }
    }
};
struct EpiResLn {
    static constexpr bool PERM = false;
    float* y; int ld; const float* stats; const float* gam; const float* bet; float alpha;
    __device__ __forceinline__ void operator()(const f32x4 (&acc)[2][2][4][2], const Unit& u, int wr, int wc, int fr, int fq) const {
        const int col0 = u.pn * BM + wc * 32 + 4 * fq;
        f32x4 gg[2][2], bb[2][2];
#pragma unroll
        for (int bj = 0; bj < 2; ++bj)
#pragma unroll
            for (int n = 0; n < 2; ++n) { gg[bj][n] = *(const f32x4*)(gam + col0 + bj * HALF + n * 16) * alpha; bb[bj][n] = *(const f32x4*)(bet + col0 + bj * HALF + n * 16) * alpha; }
#pragma unroll
        for (int ai = 0; ai < 2; ++ai)
#pragma unroll
            for (int m = 0; m < 4; ++m) { const int row = u.pm * BM + ai * HALF + wr * 64 + m * 16 + fr;
                const f32x2 st = *(const f32x2*)(stats + (size_t)row * 2);
                float* op = y + (size_t)row * ld + col0;
#pragma unroll
                for (int bj = 0; bj < 2; ++bj)
#pragma unroll
                    for (int n = 0; n < 2; ++n) { const f32x4 r = *(const f32x4*)(op + bj * HALF + n * 16); *(f32x4*)(op + bj * HALF + n * 16) = (r - st.x) * st.y * gg[bj][n] + bb[bj][n] + acc[ai][bj][m][n]; } }
    }
};
struct EpiPair {
    static constexpr bool PERM = true;
    bf16_t* Z; bf16_t* W; int ldc;
    __device__ __forceinline__ void operator()(const f32x4 (&acc)[2][2][4][2], const Unit& u, int wr, int wc, int fr, int fq) const {
        const int type = u.pn & 1, cb = u.pn >> 1; bf16_t* dst = type ? W : Z;
        const int col0 = cb * 128 + wc * 32 + 8 * fq;
#pragma unroll
        for (int ai = 0; ai < 2; ++ai)
#pragma unroll
            for (int m = 0; m < 4; ++m) { const int row = u.pm * BM + ai * HALF + wr * 64 + m * 16 + fr;
                f32x4 a0 = acc[ai][0][m][0], a1 = acc[ai][0][m][1], b0 = acc[ai][1][m][0], b1 = acc[ai][1][m][1];
                if (type) {
#pragma unroll
                    for (int j = 0; j < 4; ++j) { b0[j] = silu_f(b0[j]); b1[j] = silu_f(b1[j]); } }
                a0 = a0 * b0; a1 = a1 * b1;
                u32x4 w; w.x = cvt_pk_bf16(a0[0], a0[1]); w.y = cvt_pk_bf16(a0[2], a0[3]); w.z = cvt_pk_bf16(a1[0], a1[1]); w.w = cvt_pk_bf16(a1[2], a1[3]);
                *(u32x4*)(dst + (size_t)row * ldc + col0) = w; }
    }
};

template <class Epi, bool ALIGN_EPI = true>
__device__ __forceinline__ void gemm_phase(LAS unsigned char* lds, const Gemm g, const StaticOrder& S, const Epi& E) {
    const int tid = threadIdx.x, wid = __builtin_amdgcn_readfirstlane(tid >> 6), lane = tid & 63, wr = wid >> 2, wc = wid & 3, fr = lane & 15, fq = lane >> 4;
    const int K = g.K, nt = K / BK;
    unsigned voffA[2], voffB[2];
#pragma unroll
    for (int i = 0; i < 2; ++i) { int R, C; stage_rc(tid * 16 + i * 8192, R, C); const int Rb = Epi::PERM ? ((R & ~31) + perm32(R & 31)) : R;
        voffA[i] = (unsigned)(R * g.lda + C) * 2u; voffB[i] = (unsigned)(Rb * g.ldb + C) * 2u; }
    const size_t kstep = (size_t)(BK * 2);
    const size_t hstepA = (size_t)HALF * g.lda * 2, hstepB = (size_t)HALF * g.ldb * 2;
    const size_t tstepA = 2 * hstepA, tstepB = 2 * hstepB;
    const int tsplit = g.tsplit; const size_t ajump = (size_t)g.ajump;
    const unsigned ldsw = (unsigned)wid * 1024u;
    const int aoff = lds_byte(wr * 64 + fr, fq * 8), boff = lds_byte(wc * 32 + fr, fq * 8);
#define PG8_AK(base, ti) ((base) + (size_t)(ti) * kstep + (((ti) >= tsplit) ? ajump : (size_t)0))
#define PG8_SA(b, h) (((b) * 2 + (h)) * HTB)
#define PG8_SB(b, h) ((4 + (b) * 2 + (h)) * HTB)
#define PG8_STAGE(bufoff, gbase, voff) do { _Pragma("unroll") for (int _i = 0; _i < 2; ++_i) \
        __builtin_amdgcn_global_load_lds((const unsigned*)((const char*)(gbase) + (voff)[_i]), (LAS unsigned*)(lds + (bufoff) + ldsw + _i * 8192), 16, 0, 0); } while (0)
#define PG8_LDA(dst, b, h) do { _Pragma("unroll") for (int m = 0; m < 4; ++m) _Pragma("unroll") for (int k = 0; k < 2; ++k) dst[m][k] = *(const LAS bf16x8*)(lds + PG8_SA(b, h) + aoff + m * 2048 + k * 1024); } while (0)
#define PG8_LDB(dst, b, h) do { _Pragma("unroll") for (int n = 0; n < 2; ++n) _Pragma("unroll") for (int k = 0; k < 2; ++k) dst[n][k] = *(const LAS bf16x8*)(lds + PG8_SB(b, h) + boff + n * 2048 + k * 1024); } while (0)
#define PG8_MMA(ai, bj, At, Bt) do { __builtin_amdgcn_s_setprio(1); _Pragma("unroll") for (int m = 0; m < 4; ++m) _Pragma("unroll") for (int n = 0; n < 2; ++n) _Pragma("unroll") for (int k = 0; k < 2; ++k) \
        acc[ai][bj][m][n] = __builtin_amdgcn_mfma_f32_16x16x32_bf16(Bt[n][k], At[m][k], acc[ai][bj][m][n], 0, 0, 0); __builtin_amdgcn_s_setprio(0); } while (0)
#define PG8_WAIT_V(n) asm volatile("s_waitcnt vmcnt(" #n ")" ::: "memory")
#define PG8_WAIT_L(n) asm volatile("s_waitcnt lgkmcnt(" #n ")" ::: "memory")
#define PG8_BAR __builtin_amdgcn_s_barrier()
#define PG8_SCHED __builtin_amdgcn_sched_barrier(0)
    Unit cur, nxt; int ui = 0;
    if (!S.next(0, cur)) return;
    f32x4 acc[2][2][4][2];
#pragma unroll
    for (int a = 0; a < 2; ++a)
#pragma unroll
        for (int b = 0; b < 2; ++b)
#pragma unroll
            for (int m = 0; m < 4; ++m)
#pragma unroll
                for (int n = 0; n < 2; ++n) acc[a][b][m][n] = (f32x4){0.f, 0.f, 0.f, 0.f};
    bf16x8 At[4][2], B0[2][2], B1[2][2];
    const char* cA = (const char*)g.A + (size_t)cur.pm * tstepA + (size_t)cur.pn * g.a_pn_off * 2; const char* cB = (const char*)g.Bt + (size_t)cur.pn * tstepB;
    PG8_STAGE(PG8_SB(0, 0), cB, voffB); PG8_STAGE(PG8_SB(0, 1), cB + hstepB, voffB); PG8_STAGE(PG8_SA(0, 0), cA, voffA); PG8_STAGE(PG8_SA(0, 1), cA + hstepA, voffA);
    if (wr == 1) PG8_BAR;
    PG8_WAIT_V(2); PG8_BAR;
    PG8_STAGE(PG8_SB(1, 0), cB + kstep, voffB); PG8_STAGE(PG8_SA(1, 0), cA + kstep, voffA); PG8_STAGE(PG8_SB(1, 1), cB + hstepB + kstep, voffB);
    PG8_WAIT_V(6); PG8_BAR;
    for (;;) {
        const bool has_next = S.next(ui + 1, nxt);
        const char* nA = has_next ? (const char*)g.A + (size_t)nxt.pm * tstepA + (size_t)nxt.pn * g.a_pn_off * 2 : cA; const char* nB = has_next ? (const char*)g.Bt + (size_t)nxt.pn * tstepB : cB;
        for (int t = 0; t < nt; t += 2) {
            const bool last = (t == nt - 2);
            const char* a1 = PG8_AK(cA, t + 1);
            const char* a2 = last ? nA : PG8_AK(cA, t + 2); const char* b2 = last ? nB : cB + (size_t)(t + 2) * kstep;
            const char* a3 = last ? nA + kstep : PG8_AK(cA, t + 3); const char* b3 = b2 + kstep;
            PG8_LDB(B0, 0, 0); PG8_LDB(B1, 0, 1); PG8_SCHED; PG8_LDA(At, 0, 0); PG8_STAGE(PG8_SA(1, 1), a1 + hstepA, voffA);
            PG8_WAIT_V(8); PG8_WAIT_L(0); PG8_BAR; PG8_MMA(0, 0, At, B0); PG8_MMA(0, 1, At, B1); PG8_BAR; PG8_SCHED;
            PG8_LDA(At, 0, 1); PG8_STAGE(PG8_SB(0, 0), b2, voffB); PG8_STAGE(PG8_SB(0, 1), b2 + hstepB, voffB); PG8_STAGE(PG8_SA(0, 0), a2, voffA);
            PG8_WAIT_V(8); PG8_WAIT_L(0); PG8_BAR; PG8_MMA(1, 0, At, B0); PG8_MMA(1, 1, At, B1); PG8_BAR; PG8_SCHED;
            PG8_LDB(B0, 1, 0); PG8_LDB(B1, 1, 1); PG8_SCHED; PG8_LDA(At, 1, 0); PG8_STAGE(PG8_SA(0, 1), a2 + hstepA, voffA);
            PG8_WAIT_V(8); PG8_WAIT_L(0); PG8_BAR; PG8_MMA(0, 0, At, B0); PG8_MMA(0, 1, At, B1); PG8_BAR; PG8_SCHED;
            PG8_LDA(At, 1, 1); PG8_STAGE(PG8_SB(1, 0), b3, voffB); PG8_STAGE(PG8_SB(1, 1), b3 + hstepB, voffB); PG8_STAGE(PG8_SA(1, 0), a3, voffA);
            PG8_WAIT_V(8); PG8_WAIT_L(0); PG8_BAR; PG8_MMA(1, 0, At, B0); PG8_MMA(1, 1, At, B1); PG8_BAR; PG8_SCHED;
        }
        if constexpr (ALIGN_EPI) { if (wr == 0) PG8_BAR; }
        E(acc, cur, wr, wc, fr, fq);
        if (!has_next) break;
#pragma unroll
        for (int a = 0; a < 2; ++a)
#pragma unroll
            for (int b = 0; b < 2; ++b)
#pragma unroll
                for (int m = 0; m < 4; ++m)
#pragma unroll
                    for (int n = 0; n < 2; ++n) acc[a][b][m][n] = (f32x4){0.f, 0.f, 0.f, 0.f};
        cur = nxt; cA = nA; cB = nB; ++ui;
        if constexpr (ALIGN_EPI) { if (wr == 1) PG8_BAR; }
    }
    PG8_WAIT_V(0);
    if constexpr (!ALIGN_EPI) { if (wr == 0) PG8_BAR; }
    PG8_BAR;
#undef PG8_AK
#undef PG8_SA
#undef PG8_SB
#undef PG8_STAGE
#undef PG8_LDA
#undef PG8_LDB
#undef PG8_MMA
#undef PG8_WAIT_V
#undef PG8_WAIT_L
#undef PG8_BAR
#undef PG8_SCHED
}
}

__device__ __forceinline__ unsigned f2bf(float f) { unsigned u = __builtin_bit_cast(unsigned, f); return (u + 0x7fffu + ((u >> 16) & 1u)) >> 16; }
__device__ __forceinline__ unsigned pk2(float lo, float hi) { return f2bf(lo) | (f2bf(hi) << 16); }
__device__ __forceinline__ float bf_lo(unsigned w) { return __builtin_bit_cast(float, w << 16); }
__device__ __forceinline__ float bf_hi(unsigned w) { return __builtin_bit_cast(float, w & 0xffff0000u); }
__device__ __forceinline__ float wave_sum(float v) {
#pragma unroll
    for (int o = 1; o < 64; o <<= 1) v += __shfl_xor(v, o);
    return v;
}
__device__ __forceinline__ int t5_bucket(int rel) {
    const int n = rel < 0 ? -rel : rel; const int b = rel > 0 ? 16 : 0;
    const int v = n < 8 ? n : 8 + (n >= 15) + (n >= 27) + (n >= 50) + (n >= 91) + (n >= 166) + (n >= 305) + (n >= 559);
    return b + v;
}

__device__ __forceinline__ void transpose_item(const float* W, int N, int k0, int n0, bf16_t* WT, int ldt, int drow0, LAS float* scr, int lane) {
    float wv[32];
#pragma unroll
    for (int i = 0; i < 32; ++i) { const int kk = 2 * i + (lane >> 5); wv[i] = W[(size_t)(k0 + kk) * N + n0 + (lane & 31)]; }
#pragma unroll
    for (int i = 0; i < 32; ++i) { const int kk = 2 * i + (lane >> 5); scr[kk * 33 + (lane & 31)] = wv[i]; }
    asm volatile("s_waitcnt lgkmcnt(0)" ::: "memory");
    const int c = lane & 7;
#pragma unroll
    for (int j = 0; j < 4; ++j) { const int n = (lane >> 3) + 8 * j; const LAS float* s = scr + (8 * c) * 33 + n;
        u32x4 o; o.x = pk2(s[0 * 33], s[1 * 33]); o.y = pk2(s[2 * 33], s[3 * 33]); o.z = pk2(s[4 * 33], s[5 * 33]); o.w = pk2(s[6 * 33], s[7 * 33]);
        *(u32x4*)(WT + (size_t)(drow0 + n) * ldt + k0 + 8 * c) = o; }
    asm volatile("s_waitcnt lgkmcnt(0)" ::: "memory");
}

typedef short v4i16_t __attribute__((ext_vector_type(4)));
__device__ __forceinline__ s16x4 vtr(LAS const unsigned char* p) { return __builtin_bit_cast(s16x4, __builtin_amdgcn_ds_read_tr16_b64_v4i16((LAS v4i16_t*)p)); }

template <int PASS, bool SB = false>
__device__ __forceinline__ void attn_pass(LAS unsigned char* lds, bf16_t* RA, bf16_t* RB, bf16_t* OACC, float* LACC, const float* rel_bias, const int sb_seq = 0, const int sb_S = 0, const int sb_blk = 0, const int sb_h = 0) {
    constexpr int D = PASS == 0 ? 1 : (PASS == 1 ? 4 : 16);
    constexpr int KOFF = 0, VOFF = 69632, BOFF = 143360, PITCH = 272, VPITCH = 288;
    const int tid = threadIdx.x, lane = tid & 63, w = __builtin_amdgcn_readfirstlane(tid >> 6), fr = lane & 15, fq = lane >> 4;
    const int G = gridDim.x;
    LAS float* bias = (LAS float*)(lds + BOFF);
    const int ch = tid & 15, r0 = tid >> 4;
#define ATT_DECODE(IT) int seq_base, S_, g, qb, h; \
        if (SB) { h = sb_h; seq_base = sb_seq; S_ = sb_S; if (PASS == 0) { g = 0; qb = 4 * sb_blk + (IT); } else { g = (IT); qb = sb_blk; } } \
        else { const int c_ = (IT) >> 4; h = (IT) & 15; int cc_; if (c_ < 64) { seq_base = (c_ >> 4) * 2048; S_ = 2048; cc_ = c_ & 15; } else { seq_base = MP; S_ = 16384; cc_ = c_ - 64; } \
            const int nqb_ = (S_ / D) >> 7; g = cc_ / nqb_; qb = cc_ - g * nqb_; } \
        const int L = S_ / D, kj0 = qb * 128 - 64;
    u32x4 kv[8], vv[8]; bf16x8 qn[4];
#define ATT_LOAD() do { \
        _Pragma("unroll") for (int i = 0; i < 8; ++i) { int kj = kj0 + r0 + 32 * i; kj = kj < 0 ? 0 : (kj > L - 1 ? L - 1 : kj); \
            const unsigned off_ = (unsigned)(h * MT + seq_base + kj * D + g) * 256u + (unsigned)ch * 16u;        \
            kv[i] = *(const u32x4*)((const char*)(RA + PARTSZ) + off_); vv[i] = *(const u32x4*)((const char*)(RA + 2 * PARTSZ) + off_); } \
        const int qrow_ = seq_base + (qb * 128 + 16 * w + fr) * D + g; \
        _Pragma("unroll") for (int kk = 0; kk < 4; ++kk) qn[kk] = *(const bf16x8*)((const char*)RA + ((unsigned)(h * MT + qrow_) * 256u + (unsigned)(kk * 64 + fq * 16))); } while (0)
    int item = SB ? 0 : (int)blockIdx.x; const int item_end = SB ? 4 : 3072, item_step = SB ? 1 : G;
    const bool hoist = SB || (G & 15) == 0;
    if (hoist && tid < 200) { const int bi = tid - 32; bias[tid] = (bi >= 0 && bi <= 128) ? rel_bias[t5_bucket((bi - 64) * D) * 16 + (SB ? sb_h : (item & 15))] * LOG2E : -1.0e30f; }
    if (item < item_end) { ATT_DECODE(item) ATT_LOAD(); }
    for (; item < item_end; item += item_step) {
        ATT_DECODE(item)
#pragma unroll
        for (int i = 0; i < 8; ++i) { const int r = r0 + 32 * i;
            *(LAS u32x4*)(lds + KOFF + r * PITCH + ch * 16) = kv[i]; *(LAS u32x4*)(lds + VOFF + r * VPITCH + ch * 16) = vv[i]; }
        if (!hoist) { if (tid < 200) { const int bi = tid - 32; bias[tid] = (bi >= 0 && bi <= 128) ? rel_bias[t5_bucket((bi - 64) * D) * 16 + h] * LOG2E : -1.0e30f; } }
        bf16x8 qf[4];
#pragma unroll
        for (int kk = 0; kk < 4; ++kk) qf[kk] = qn[kk];
        const int qrow = seq_base + (qb * 128 + 16 * w + fr) * D + g;
        asm volatile("s_waitcnt lgkmcnt(0)\n\ts_barrier" ::: "memory");
        if (item + item_step < item_end) { const int nit = item + item_step; ATT_DECODE(nit) ATT_LOAD(); }
        const int ts = w & ~1;
        f32x4 s[10];
        {
            LAS const unsigned char* kptr = lds + KOFF + (16 * ts + fr) * PITCH + fq * 16;
            bf16x8 kf[2][2][4];
#define ATT_LDK(BUF, TP) _Pragma("unroll") for (int u = 0; u < 2; ++u) _Pragma("unroll") for (int kk = 0; kk < 4; ++kk) kf[BUF][u][kk] = *(const LAS bf16x8*)(kptr + (16 * (2 * (TP) + u)) * PITCH + kk * 64);
            ATT_LDK(0, 0)
#pragma unroll
            for (int tp = 0; tp < 5; ++tp) {
                if (tp + 1 < 5) { ATT_LDK((tp + 1) & 1, tp + 1) }
                __builtin_amdgcn_sched_barrier(0);
                s[2 * tp] = (f32x4){0.f, 0.f, 0.f, 0.f}; s[2 * tp + 1] = (f32x4){0.f, 0.f, 0.f, 0.f};
                if (tp == 0 && (w & 1)) {
#pragma unroll
                    for (int kk = 0; kk < 4; ++kk) s[1] = __builtin_amdgcn_mfma_f32_16x16x32_bf16(kf[0][1][kk], qf[kk], s[1], 0, 0, 0);
                } else if (tp == 4 && !(w & 1)) {
#pragma unroll
                    for (int kk = 0; kk < 4; ++kk) s[8] = __builtin_amdgcn_mfma_f32_16x16x32_bf16(kf[0][0][kk], qf[kk], s[8], 0, 0, 0);
                } else {
#pragma unroll
                for (int kk = 0; kk < 4; ++kk) { s[2 * tp] = __builtin_amdgcn_mfma_f32_16x16x32_bf16(kf[tp & 1][0][kk], qf[kk], s[2 * tp], 0, 0, 0);
                    s[2 * tp + 1] = __builtin_amdgcn_mfma_f32_16x16x32_bf16(kf[tp & 1][1][kk], qf[kk], s[2 * tp + 1], 0, 0, 0); } }
                __builtin_amdgcn_sched_barrier(0);
            }
#undef ATT_LDK
        }
        const int kb = 16 * ts + 4 * fq;
        LAS const float* bl = bias + (kb - (16 * w + fr) + 32);
        float mx = -3.0e38f;
        if (kj0 >= 0 && kj0 + 255 < L) {
#pragma unroll
            for (int t = 0; t < 10; ++t)
#pragma unroll
                for (int i = 0; i < 4; ++i) { const float v = s[t][i] + bl[16 * t + i]; s[t][i] = v; mx = fmaxf(mx, v); }
        } else {
#pragma unroll
            for (int t = 0; t < 10; ++t)
#pragma unroll
                for (int i = 0; i < 4; ++i) { const int kj = kj0 + kb + 16 * t + i;
                    const float v = ((unsigned)kj < (unsigned)L) ? s[t][i] + bl[16 * t + i] : -1.0e30f; s[t][i] = v; mx = fmaxf(mx, v); }
        }
        mx = fmaxf(mx, __shfl_xor(mx, 16)); mx = fmaxf(mx, __shfl_xor(mx, 32));
        float l = 0.f;
#pragma unroll
        for (int t = 0; t < 10; ++t)
#pragma unroll
            for (int i = 0; i < 4; ++i) { const float p = __builtin_amdgcn_exp2f(s[t][i] - mx); s[t][i] = p; l += p; }
        l += __shfl_xor(l, 16); l += __shfl_xor(l, 32);
        bf16x8 pf[5];
#pragma unroll
        for (int b = 0; b < 5; ++b) { u32x4 u; u.x = pg8::cvt_pk_bf16(s[2 * b][0], s[2 * b][1]); u.y = pg8::cvt_pk_bf16(s[2 * b][2], s[2 * b][3]);
            u.z = pg8::cvt_pk_bf16(s[2 * b + 1][0], s[2 * b + 1][1]); u.w = pg8::cvt_pk_bf16(s[2 * b + 1][2], s[2 * b + 1][3]); pf[b] = __builtin_bit_cast(bf16x8, u); }
        float Lp = 0.f; u32x2 pv[8]; u32x2 gv[8];
        if (PASS > 0) { Lp = LACC[(size_t)qrow * 16 + h];
#pragma unroll
            for (int db = 0; db < 8; ++db) pv[db] = *(const u32x2*)((const char*)OACC + ((unsigned)(h * MT + qrow) * 256u + (unsigned)(32 * db + 8 * fq))); }
        if (PASS == 2) {
#pragma unroll
            for (int db = 0; db < 8; ++db) gv[db] = *(const u32x2*)((const char*)RB + ((unsigned)qrow * (unsigned)(LDB * 2) + (unsigned)(h * 256 + 32 * db + 8 * fq))); }
        f32x4 o[8];
        const int q4 = (lane & 15) >> 2, p4 = lane & 3;
        LAS const unsigned char* vbase = lds + VOFF + (16 * ts + 4 * fq + q4) * VPITCH + p4 * 8;
        {
            s16x4 vl[2][5], vh[2][5];
#define ATT_LDV(BUF, DB) _Pragma("unroll") for (int b = 0; b < 5; ++b) { vl[BUF][b] = vtr(vbase + (32 * b) * VPITCH + (DB) * 32); vh[BUF][b] = vtr(vbase + (32 * b + 16) * VPITCH + (DB) * 32); }
            ATT_LDV(0, 0)
#pragma unroll
            for (int db = 0; db < 8; ++db) {
                if (db + 1 < 8) { ATT_LDV((db + 1) & 1, db + 1) }
                __builtin_amdgcn_sched_barrier(0);
                o[db] = (f32x4){0.f, 0.f, 0.f, 0.f};
#pragma unroll
                for (int b = 0; b < 5; ++b) { const s16x4 lo = vl[db & 1][b], hi = vh[db & 1][b];
                    const bf16x8 vf = (bf16x8){lo[0], lo[1], lo[2], lo[3], hi[0], hi[1], hi[2], hi[3]};
                    o[db] = __builtin_amdgcn_mfma_f32_16x16x32_bf16(vf, pf[b], o[db], 0, 0, 0); }
                __builtin_amdgcn_sched_barrier(0);
            }
#undef ATT_LDV
        }
        const float rl = 1.0f / l;
        float Lc = mx + __builtin_amdgcn_logf(l);
        float wb = rl, wa = 0.f;
        if (PASS > 0) { const float Lm = fmaxf(Lp, Lc);
            const float ea = __builtin_amdgcn_exp2f(Lp - Lm), eb = __builtin_amdgcn_exp2f(Lc - Lm), den = ea + eb, rd = 1.0f / den;
            wa = ea * rd; wb = eb * rd * rl; Lc = Lm + __builtin_amdgcn_logf(den); }
        if (PASS < 2) { if (fq == 0) LACC[(size_t)qrow * 16 + h] = Lc; }
#pragma unroll
        for (int db = 0; db < 8; ++db) { f32x4 v = o[db] * wb;
            const size_t ocol = (size_t)h * 128 + 16 * db + 4 * fq;
            if (PASS > 0) { v[0] += wa * bf_lo(pv[db].x); v[1] += wa * bf_hi(pv[db].x); v[2] += wa * bf_lo(pv[db].y); v[3] += wa * bf_hi(pv[db].y); }
            if (PASS < 2) { u32x2 ov; ov.x = pg8::cvt_pk_bf16(v[0], v[1]); ov.y = pg8::cvt_pk_bf16(v[2], v[3]); *(u32x2*)((char*)OACC + ((unsigned)(h * MT + qrow) * 256u + (unsigned)(32 * db + 8 * fq))) = ov; }
            else { v[0] *= pg8::silu_f(bf_lo(gv[db].x)); v[1] *= pg8::silu_f(bf_hi(gv[db].x)); v[2] *= pg8::silu_f(bf_lo(gv[db].y)); v[3] *= pg8::silu_f(bf_hi(gv[db].y));
                u32x2 ov; ov.x = pg8::cvt_pk_bf16(v[0], v[1]); ov.y = pg8::cvt_pk_bf16(v[2], v[3]); *(u32x2*)((char*)RB + ((unsigned)qrow * (unsigned)(LDB * 2) + (unsigned)(h * 256 + 32 * db + 8 * fq))) = ov; } }
        asm volatile("s_waitcnt lgkmcnt(0)\n\ts_barrier" ::: "memory");
    }
#undef ATT_DECODE
#undef ATT_LOAD
}

#define XB_TMO      128
#define XB_XCNT(j)  (256  + 64 * (j))
#define XB_XSUB(j)  (1280 + 64 * (j))
#define XB_XGEN(j)  (2304 + 64 * (j))
#define XB_TOP      3328
#define XB_TOPGEN   3392
#define XCD_BAR_WORDS 3456
#define XB_SPIN_CAP (1u << 18)
__device__ __forceinline__ unsigned xb_ld(unsigned* p)              { return __hip_atomic_load(p, __ATOMIC_RELAXED, __HIP_MEMORY_SCOPE_AGENT); }
__device__ __forceinline__ unsigned xb_add(unsigned* p, unsigned v) { return __hip_atomic_fetch_add(p, v, __ATOMIC_RELAXED, __HIP_MEMORY_SCOPE_AGENT); }
__device__ __forceinline__ unsigned xb_xcc_id() { return (unsigned)__builtin_amdgcn_s_getreg((3 << 11) | 20) & 0xFu; }
#define XB_SPIN(cond, bar) do { unsigned _sp = 0; while (cond) { __builtin_amdgcn_s_sleep(1); \
    if ((++_sp & 255u) == 0u) { if (xb_ld(&(bar)[XB_TMO])) break; if (_sp > XB_SPIN_CAP) { atomicAdd(&(bar)[XB_TMO], 1u); break; } } } } while (0)
struct XcdBarrier { unsigned* bar; unsigned x; volatile LAS unsigned* st; };
__device__ __forceinline__ XcdBarrier xcd_barrier_post(unsigned* bar, volatile LAS unsigned* st) {
    XcdBarrier b; b.bar = bar; b.x = xb_xcc_id(); b.st = st;
    if (threadIdx.x == 0) (void)xb_add(&bar[XB_XCNT(b.x)], 1u);
    return b;
}
__device__ __forceinline__ void xcd_barrier_complete(unsigned* bar, unsigned x, unsigned& nloc, unsigned& nx) {
    const unsigned G = gridDim.x * gridDim.y * gridDim.z;
    unsigned sum, cnt, mine, sp = 0u;
    for (;;) {
        sum = 0u; cnt = 0u; mine = 0u;
#pragma unroll
        for (unsigned j = 0; j < 16; ++j) { const unsigned c = xb_ld(&bar[XB_XCNT(j)]); sum += c; cnt += (c > 0u) ? 1u : 0u; mine = (j == x) ? c : mine; }
        if (sum == G) break;
        __builtin_amdgcn_s_sleep(1);
        if ((++sp & 255u) == 0u) { if (xb_ld(&bar[XB_TMO])) break; if (sp > XB_SPIN_CAP) { atomicAdd(&bar[XB_TMO], 1u); break; } }
    }
    nloc = mine > 0u ? mine : 1u; nx = cnt > 0u ? cnt : 1u;
}
__device__ __forceinline__ void xcd_barrier(const XcdBarrier& b) {
    asm volatile("s_waitcnt vmcnt(0)" ::: "memory");
    __syncthreads();
    if (threadIdx.x == 0) {
        unsigned* bar = b.bar;
        __builtin_amdgcn_s_waitcnt(0);
        unsigned nloc = b.st[0], nx = b.st[1];
        if (nloc == 0u) { xcd_barrier_complete(bar, b.x, nloc, nx); b.st[0] = nloc; b.st[1] = nx; }
        const unsigned old = xb_add(&bar[XB_XSUB(b.x)], 1u);
        const unsigned gen = old / nloc;
        if (old + 1u == (gen + 1u) * nloc) {
            __builtin_amdgcn_fence(__ATOMIC_RELEASE, "agent");
            asm volatile("s_waitcnt vmcnt(0)" ::: "memory");
            const unsigned og = xb_add(&bar[XB_TOP], 1u);
            const unsigned tg = og / nx;
            if (og + 1u == (tg + 1u) * nx) xb_add(&bar[XB_TOPGEN], 1u);
            else XB_SPIN(xb_ld(&bar[XB_TOPGEN]) == tg, bar);
            __builtin_amdgcn_fence(__ATOMIC_ACQUIRE, "agent");
            xb_add(&bar[XB_XGEN(b.x)], 1u);
            asm volatile("s_waitcnt vmcnt(0)" ::: "memory");
        } else {
            XB_SPIN(xb_ld(&bar[XB_XGEN(b.x)]) == gen, bar);
            __builtin_amdgcn_fence(__ATOMIC_ACQUIRE, "agent");
            asm volatile("s_waitcnt vmcnt(0)" ::: "memory");
        }
    }
    __syncthreads();
}

struct Args { const float* in[12]; float* out; unsigned char* ws; };

__global__ void __launch_bounds__(512, 2) fwd_megakernel(Args a) {
    extern __shared__ __attribute__((aligned(16))) unsigned char lds_raw[];
    LAS unsigned char* lds = (LAS unsigned char*)lds_raw;
    cg::grid_group grid = cg::this_grid();
    const int tid = threadIdx.x, lane = tid & 63, wave = __builtin_amdgcn_readfirstlane(tid >> 6);
    const int G = gridDim.x, bx = blockIdx.x;
    const float* x_prompt = a.in[0]; const float* x_sample = a.in[1]; const float* rel_bias = a.in[2];
    const float* w_in_ab = a.in[3]; const float* pool_w = a.in[4]; const float* pool_scale = a.in[5]; const float* w_out_ab = a.in[6];
    const float* w_in_c = a.in[7]; const float* conv_w = a.in[8]; const float* w_out_c = a.in[9]; const float* ln_g = a.in[10]; const float* ln_b = a.in[11];
    unsigned char* dout = (unsigned char*)a.out;
    bf16_t* XB = (bf16_t*)(dout + DO_XB); bf16_t* OACC = XB;
    bf16_t* WT1 = (bf16_t*)(dout + DO_WT1); bf16_t* WT2 = (bf16_t*)(dout + DO_WT2); bf16_t* WT3 = (bf16_t*)(dout + DO_WT3);
    bf16_t* WT4 = (bf16_t*)(dout + DO_WT4); bf16_t* WT5 = (bf16_t*)(dout + DO_WT5);
    bf16_t* RA = (bf16_t*)(a.ws + WS_H0); bf16_t* RB = (bf16_t*)(a.ws + WS_RB); float* LACC = (float*)(a.ws + WS_LACC); float* STAT = (float*)(a.ws + WS_STAT);
    const int gw = bx * 8 + wave, NGW = G * 8;
    const int gt = bx * 512 + tid, NGT = G * 512;
    constexpr int BIG = 1 << 30;
    unsigned* barw = (unsigned*)(a.ws + WS_BAR);
    volatile LAS unsigned* lds_st = (volatile LAS unsigned*)(lds + LDS_BYTES - 64);
    if (bx == 0) { for (int i = tid; i < XCD_BAR_WORDS; i += 512) barw[i] = 0u; }
    if (tid < 2) lds_st[tid] = 0u;
    __syncthreads();

    for (int rep = 0; rep < (EXP == 3 ? 2 : 1); ++rep) {
        LAS float* scr = (LAS float*)(lds + wave * 16384);
        constexpr int I1 = 32 * 320, I2 = 48 * 64, I3 = 32 * 256, I4 = 32 * 64, I5 = 4 * 4 * 8;
        for (int it = gw; it < I1 + I2 + I3 + I4 + I5; it += NGW) {
            int r = it;
            if (r < I1) { const int kb = r / 320, nb = r % 320; transpose_item(w_in_ab, 10240, 64 * kb, 32 * nb, WT1, 2048, 32 * nb, scr, lane); continue; } r -= I1;
            if (r < I2) { const int kb = r / 64, nb = r % 64; transpose_item(w_out_ab, 2048, 64 * kb, 32 * nb, WT2, 3072, 32 * nb, scr, lane); continue; } r -= I2;
            if (r < I3) { const int kb = r / 256, nb = r % 256; const int n0 = 32 * nb, part = n0 >> 11, chn = n0 & 2047;
                const int type = (part == 0 || part == 3) ? 1 : 0, bj = (part >= 2) ? 1 : 0;
                const int drow = 256 * (2 * (chn >> 7) + type) + 128 * bj + (chn & 127);
                transpose_item(w_in_c, 8192, 64 * kb, n0, WT3, 2048, drow, scr, lane); continue; } r -= I3;
            if (r < I4) { const int kb = r / 64, nb = r % 64; transpose_item(w_out_c, 2048, 64 * kb, 32 * nb, WT4, 2048, 32 * nb, scr, lane); continue; } r -= I4;
            { const int gi = r >> 5, rr = r & 31, kb = rr >> 3, nb = rr & 7; transpose_item(pool_w + (size_t)gi * 65536, 256, 64 * kb, 32 * nb, WT5, 256, gi * 256 + 32 * nb, scr, lane); }
        }
        for (size_t i = gt; i < (size_t)MT * DM / 8; i += (size_t)NGT * 4) {
            f32x4 v0[4], v1[4];
#pragma unroll
            for (int u = 0; u < 4; ++u) { const size_t ii = i + (size_t)u * NGT; if (ii < (size_t)MT * DM / 8) { const size_t e = ii * 8; const float* src = e < (size_t)MP * DM ? x_prompt + e : x_sample + (e - (size_t)MP * DM);
                v0[u] = *(const f32x4*)src; v1[u] = *(const f32x4*)(src + 4); } }
#pragma unroll
            for (int u = 0; u < 4; ++u) { const size_t ii = i + (size_t)u * NGT; if (ii < (size_t)MT * DM / 8) { const size_t e = ii * 8;
                u32x4 o; o.x = pk2(v0[u][0], v0[u][1]); o.y = pk2(v0[u][2], v0[u][3]); o.z = pk2(v1[u][0], v1[u][1]); o.w = pk2(v1[u][2], v1[u][3]);
                *(u32x4*)(XB + e) = o; } } }
    }
    grid.sync();
    XcdBarrier xbar = xcd_barrier_post(barw, lds_st);
#define GRID_SYNC() xcd_barrier(xbar)
    if (EXP == 4) { for (int r = 0; r < 10; ++r) GRID_SYNC(); }
    {
        { pg8::Gemm g{XB, WT1, MT, 6144, 2048, 2048, 2048, 0, BIG, 0}; pg8::StaticOrder S; S.init(MT, 6144, G, bx);
          pg8::EpiHead E{RA, QSCALE};
          pg8::gemm_phase<pg8::EpiHead>(lds, g, S, E); }
        __syncthreads();
        { pg8::Gemm g{XB, WT1 + (size_t)6144 * 2048, MT, 4096, 2048, 2048, 2048, 0, BIG, 0}; pg8::StaticOrder S; S.init(MT, 4096, G, bx);
          pg8::EpiBf16 E{RB, LDB, 0, 1.f};
          pg8::gemm_phase<pg8::EpiBf16>(lds, g, S, E); }
    }
    GRID_SYNC();
    {
        pg8::Gemm g{RB + B_UB, WT5, MT, 1024, 256, LDB, 256, 256, BIG, 0}; pg8::StaticOrder S; S.init(MT, 1024, G, bx);
        pg8::EpiBf16 E{RB + B_UB, LDB, 0, 1.f};
        pg8::gemm_phase<pg8::EpiBf16, false>(lds, g, S, E);
        __syncthreads();
        for (int sb = bx; sb < 768; sb += G) {
            const int c5 = sb >> 4, sbh = sb & 15; int sseq, sS, sblk;
            if (c5 < 16) { sseq = (c5 >> 2) * 2048; sS = 2048; sblk = c5 & 3; } else { sseq = MP; sS = 16384; sblk = c5 - 16; }
            attn_pass<0, true>(lds, RA, RB, OACC, LACC, rel_bias, sseq, sS, sblk, sbh);
            asm volatile("s_waitcnt vmcnt(0)" ::: "memory"); __syncthreads();
            attn_pass<1, true>(lds, RA, RB, OACC, LACC, rel_bias, sseq, sS, sblk, sbh);
        }
    }
    GRID_SYNC();
    {
#define POOL_GROUP(GI) \
        for (int idx = gt; idx < MT * 32; idx += NGT) { \
            constexpr int HW = 1 << (GI), WIN = 2 * HW; \
            const int row = idx >> 5, c0 = (GI) * 256 + (idx & 31) * 8; \
            int t, S; if (row < MP) { t = row & 2047; S = 2048; } else { t = row - MP; S = 16384; } \
            const bf16_t* base = RB + (size_t)(row - t) * LDB + B_UB + c0; \
            u32x4 v[WIN]; \
            _Pragma("unroll") for (int k = 0; k < WIN; ++k) { int tt = t - HW + k; tt = tt < 0 ? 0 : (tt > S - 1 ? S - 1 : tt); v[k] = *(const u32x4*)(base + (size_t)tt * LDB); } \
            bf16_t* gp = RB + (size_t)row * LDB + B_GB + c0; \
            const u32x4 gv = *(const u32x4*)gp; \
            const f32x4 sc0 = *(const f32x4*)(pool_scale + c0), sc1 = *(const f32x4*)(pool_scale + c0 + 4); \
            float acc8[8]; \
            _Pragma("unroll") for (int j = 0; j < 8; ++j) acc8[j] = 0.f; \
            _Pragma("unroll") for (int k = 0; k < WIN; ++k) { const int tt = t - HW + k; const float m = (tt >= 0 && tt < S) ? 1.f : 0.f; \
                acc8[0] += m * bf_lo(v[k].x); acc8[1] += m * bf_hi(v[k].x); acc8[2] += m * bf_lo(v[k].y); acc8[3] += m * bf_hi(v[k].y); \
                acc8[4] += m * bf_lo(v[k].z); acc8[5] += m * bf_hi(v[k].z); acc8[6] += m * bf_lo(v[k].w); acc8[7] += m * bf_hi(v[k].w); } \
            const int lo = (t - HW) < 0 ? 0 : t - HW, hi = (t + HW - 1) > S - 1 ? S - 1 : t + HW - 1; \
            const float rc = 1.0f / (float)(hi - lo + 1); \
            const u32x4 sv = v[HW]; \
            float r8[8]; \
            r8[0] = (acc8[0] * rc - bf_lo(sv.x)) * sc0[0] * pg8::silu_f(bf_lo(gv.x)); r8[1] = (acc8[1] * rc - bf_hi(sv.x)) * sc0[1] * pg8::silu_f(bf_hi(gv.x)); \
            r8[2] = (acc8[2] * rc - bf_lo(sv.y)) * sc0[2] * pg8::silu_f(bf_lo(gv.y)); r8[3] = (acc8[3] * rc - bf_hi(sv.y)) * sc0[3] * pg8::silu_f(bf_hi(gv.y)); \
            r8[4] = (acc8[4] * rc - bf_lo(sv.z)) * sc1[0] * pg8::silu_f(bf_lo(gv.z)); r8[5] = (acc8[5] * rc - bf_hi(sv.z)) * sc1[1] * pg8::silu_f(bf_hi(gv.z)); \
            r8[6] = (acc8[6] * rc - bf_lo(sv.w)) * sc1[2] * pg8::silu_f(bf_lo(gv.w)); r8[7] = (acc8[7] * rc - bf_hi(sv.w)) * sc1[3] * pg8::silu_f(bf_hi(gv.w)); \
            u32x4 o; o.x = pk2(r8[0], r8[1]); o.y = pk2(r8[2], r8[3]); o.z = pk2(r8[4], r8[5]); o.w = pk2(r8[6], r8[7]); \
            *(u32x4*)gp = o; }
        POOL_GROUP(0) POOL_GROUP(1) POOL_GROUP(2) POOL_GROUP(3)
#undef POOL_GROUP
    }
    attn_pass<2>(lds, RA, RB, OACC, LACC, rel_bias);
    GRID_SYNC();
    {
        pg8::Gemm g{RB, WT2, MT, 2048, 3072, LDB, 3072, 0, 32, (B_GB - 2048) * 2}; pg8::StaticOrder S; S.init(MT, 2048, G, bx);
        pg8::EpiResBf E{x_prompt, x_sample, MP, DM, RA + A_Y0, LDA, DN_ALPHA};
        pg8::gemm_phase<pg8::EpiResBf>(lds, g, S, E);
    }
    GRID_SYNC();
#define LN_PHASE(LAYER, SRC_COL, WRITE_BF, WRITE_F32) { \
    int ln_lane = (int)__builtin_amdgcn_mbcnt_hi(~0u, __builtin_amdgcn_mbcnt_lo(~0u, 0u)); asm volatile("" : "+v"(ln_lane));        \
    f32x4 gg[8], bb[8]; \
    _Pragma("unroll") for (int j = 0; j < 4; ++j) { const float* gp_ = ln_g + (LAYER) * DM + 8 * (ln_lane + 64 * j); const float* bp_ = ln_b + (LAYER) * DM + 8 * (ln_lane + 64 * j); \
        gg[2 * j] = *(const f32x4*)gp_; gg[2 * j + 1] = *(const f32x4*)(gp_ + 4); bb[2 * j] = *(const f32x4*)bp_; bb[2 * j + 1] = *(const f32x4*)(bp_ + 4); } \
    u32x4 rv[4], rn[4]; int row = gw; \
    if (row < MT) { const u32x4* src = (const u32x4*)(RA + (size_t)row * LDA + (SRC_COL)) + ln_lane; _Pragma("unroll") for (int j = 0; j < 4; ++j) rv[j] = src[64 * j]; } \
    while (row < MT) { \
        const int nrow = row + NGW; \
        if (nrow < MT) { const u32x4* srcn = (const u32x4*)(RA + (size_t)nrow * LDA + (SRC_COL)) + ln_lane; _Pragma("unroll") for (int j = 0; j < 4; ++j) rn[j] = srcn[64 * j]; } \
        f32x4 v[8]; float s = 0.f; \
        _Pragma("unroll") for (int j = 0; j < 4; ++j) { v[2 * j] = (f32x4){hlo(rv[j].x), hhi(rv[j].x), hlo(rv[j].y), hhi(rv[j].y)}; v[2 * j + 1] = (f32x4){hlo(rv[j].z), hhi(rv[j].z), hlo(rv[j].w), hhi(rv[j].w)}; } \
        _Pragma("unroll") for (int j = 0; j < 8; ++j) { s += (v[j][0] + v[j][1]) + (v[j][2] + v[j][3]); } \
        const float mean = wave_sum(s) * (1.0f / DM); float s2 = 0.f; \
        _Pragma("unroll") for (int j = 0; j < 8; ++j) { v[j] = v[j] - mean; s2 += (v[j][0] * v[j][0] + v[j][1] * v[j][1]) + (v[j][2] * v[j][2] + v[j][3] * v[j][3]); } \
        const float rstd = 1.0f / sqrtf(wave_sum(s2) * (1.0f / DM) + LN_EPS); \
        if ((WRITE_BF) && ln_lane == 0) { *(f32x2*)(STAT + (size_t)row * 2) = (f32x2){mean, rstd}; } \
        _Pragma("unroll") for (int j = 0; j < 4; ++j) { \
            const f32x4 y0 = v[2 * j] * rstd * gg[2 * j] + bb[2 * j], y1 = v[2 * j + 1] * rstd * gg[2 * j + 1] + bb[2 * j + 1]; \
            if (WRITE_F32) { float* dp_ = a.out + (size_t)row * DM + 8 * (ln_lane + 64 * j); *(f32x4*)dp_ = y0; *(f32x4*)(dp_ + 4) = y1; } \
            if (WRITE_BF) { u32x4 o; o.x = pk2(y0[0], y0[1]); o.y = pk2(y0[2], y0[3]); o.z = pk2(y1[0], y1[1]); o.w = pk2(y1[2], y1[3]); *((u32x4*)(RA + (size_t)row * LDA + A_X1) + ln_lane + 64 * j) = o; } } \
        _Pragma("unroll") for (int j = 0; j < 4; ++j) rv[j] = rn[j]; \
        row = nrow; } }
    LN_PHASE(0, A_Y0, true, false)
    GRID_SYNC();
    {
        pg8::Gemm g{RA + A_X1, WT3, MT, 8192, 2048, LDA, 2048, 0, BIG, 0}; pg8::StaticOrder S; S.init(MT, 8192, G, bx);
        pg8::EpiPair E{RB, RB + 2048, LDB};
        pg8::gemm_phase<pg8::EpiPair>(lds, g, S, E);
    }
    GRID_SYNC();
    for (int rep = 0; rep < (EXP == 5 ? 2 : 1); ++rep)
    for (int idx0 = gt; idx0 < MT * 256; idx0 += 2 * NGT) {
        u32x4 z0[2], z1[2], z2[2], wg[2]; f32x4 cw[2][3][2];
#pragma unroll
        for (int u = 0; u < 2; ++u) { const int idx = idx0 + u * NGT; if (idx < MT * 256) {
            const int row = idx >> 8, c0 = (idx & 255) * 8;
            int t, S; if (row < MP) { t = row & 2047; S = 2048; } else { t = row - MP; S = 16384; }
            const bf16_t* zp = RB + (size_t)row * LDB + c0;
            z1[u] = *(const u32x4*)zp; z0[u] = (u32x4){0u, 0u, 0u, 0u}; z2[u] = (u32x4){0u, 0u, 0u, 0u};
            if (t > 0) z0[u] = *(const u32x4*)(zp - LDB);
            if (t < S - 1) z2[u] = *(const u32x4*)(zp + LDB);
            wg[u] = *(const u32x4*)(zp + 2048);
#pragma unroll
            for (int k = 0; k < 3; ++k) { cw[u][k][0] = *(const f32x4*)(conv_w + k * 2048 + c0); cw[u][k][1] = *(const f32x4*)(conv_w + k * 2048 + c0 + 4); } } }
#pragma unroll
        for (int u = 0; u < 2; ++u) { const int idx = idx0 + u * NGT; if (idx < MT * 256) {
            const int row = idx >> 8, c0 = (idx & 255) * 8;
            float r8[8];
#define CONV1(J, Z0, Z1, Z2, WG) r8[J] = (WG) * (cw[u][0][(J) >> 2][(J) & 3] * (Z0) + cw[u][1][(J) >> 2][(J) & 3] * (Z1) + cw[u][2][(J) >> 2][(J) & 3] * (Z2));
            CONV1(0, bf_lo(z0[u].x), bf_lo(z1[u].x), bf_lo(z2[u].x), bf_lo(wg[u].x)) CONV1(1, bf_hi(z0[u].x), bf_hi(z1[u].x), bf_hi(z2[u].x), bf_hi(wg[u].x))
            CONV1(2, bf_lo(z0[u].y), bf_lo(z1[u].y), bf_lo(z2[u].y), bf_lo(wg[u].y)) CONV1(3, bf_hi(z0[u].y), bf_hi(z1[u].y), bf_hi(z2[u].y), bf_hi(wg[u].y))
            CONV1(4, bf_lo(z0[u].z), bf_lo(z1[u].z), bf_lo(z2[u].z), bf_lo(wg[u].z)) CONV1(5, bf_hi(z0[u].z), bf_hi(z1[u].z), bf_hi(z2[u].z), bf_hi(wg[u].z))
            CONV1(6, bf_lo(z0[u].w), bf_lo(z1[u].w), bf_lo(z2[u].w), bf_lo(wg[u].w)) CONV1(7, bf_hi(z0[u].w), bf_hi(z1[u].w), bf_hi(z2[u].w), bf_hi(wg[u].w))
#undef CONV1
            u32x4 o; o.x = pk2(r8[0], r8[1]); o.y = pk2(r8[2], r8[3]); o.z = pk2(r8[4], r8[5]); o.w = pk2(r8[6], r8[7]);
            *(u32x4*)(RA + (size_t)row * LDA + A_X1 + c0) = o; } } }
    GRID_SYNC();
    {
        pg8::Gemm g{RA + A_X1, WT4, MT, 2048, 2048, LDA, 2048, 0, BIG, 0}; pg8::StaticOrder S; S.init(MT, 2048, G, bx);
        pg8::EpiResLnBf E{RA + A_Y0, LDA, STAT, ln_g, ln_b, RA + A_Y1, LDA, DN_ALPHA};
        pg8::gemm_phase<pg8::EpiResLnBf>(lds, g, S, E);
    }
    GRID_SYNC();
    LN_PHASE(1, A_Y1, false, true)
#undef LN_PHASE
}

extern "C" void kernel_launch(void* const* d_in, const int* in_sizes, int n_in, void* d_out, int out_size, void* d_ws, size_t ws_size, hipStream_t stream) {
    static int grid = 0;
    if (grid == 0) {
        if (n_in != 12 || out_size != MT * DM || ws_size < WS_END) { fprintf(stderr, "kernel_launch: unexpected shapes (n_in %d out %d ws %zu need %zu)\n", n_in, out_size, ws_size, (size_t)WS_END); grid = -1; return; }
        int dev = 0, cus = 0, per_cu = 0;
        (void)hipGetDevice(&dev); (void)hipDeviceGetAttribute(&cus, hipDeviceAttributeMultiprocessorCount, dev);
        (void)hipFuncSetAttribute((const void*)fwd_megakernel, hipFuncAttributeMaxDynamicSharedMemorySize, LDS_BYTES);
        (void)hipOccupancyMaxActiveBlocksPerMultiprocessor(&per_cu, (const void*)fwd_megakernel, 512, LDS_BYTES);
        (void)hipGetLastError();
        if (per_cu < 1) per_cu = 1;
        if (cus < 1) cus = 256;
        grid = cus;
    }
    if (grid < 0) return;
    Args a{};
    for (int i = 0; i < 12; ++i) a.in[i] = (const float*)d_in[i];
    a.out = (float*)d_out; a.ws = (unsigned char*)d_ws;
    void* args[] = {&a};
    hipError_t e = hipLaunchCooperativeKernel((const void*)fwd_megakernel, dim3(grid), dim3(512), args, LDS_BYTES, stream);
    if (e != hipSuccess) fprintf(stderr, "cooperative launch failed: %s (grid %d)\n", hipGetErrorString(e), grid);
}
```
